# Optimizing an MI355X kernel written in HIP

```python
import math
import jax, jax.numpy as jnp
from jax import lax
import numpy as np

D_MODEL = 1024
BATCH = 8
SEQ = 4096
DEPTH = 2

GRID_W = 64
CTX_LEN = 256
ATT_HEADS = 8
ATT_DH = 64
ATT_DV = 2 * ATT_DH
ATT_QBLOCK = 128
GM_WIDTH = 1024
GM_GROUPS = 8
GM_CHUNK = 128
HG_HEADS = 8
HG_DK = 128
HG_DV = 128
HG_CHUNK = 64
N_BRANCH = 3
D_FF = 2816
CONV_W = 3
ROPE_BASE = 10000.0
EPS = 1e-6

ATT_QW = ATT_HEADS * 2 * ATT_DH
ATT_VW = ATT_HEADS * ATT_DV
HG_KW = HG_HEADS * HG_DK
HG_VW = HG_HEADS * HG_DV
IN_SPLITS = (ATT_QW, ATT_QW, ATT_VW, GM_WIDTH, GM_WIDTH, HG_KW, HG_KW, HG_KW, HG_VW, HG_VW, N_BRANCH * D_MODEL)
IN_W = sum(IN_SPLITS)

kernel_name = "hybrid_diffattn_gmlp_hgrn2_dit_block"


def rmsnorm(x, g):
    xf = x.astype(jnp.float32)
    y = xf * lax.rsqrt(jnp.mean(xf * xf, axis=-1, keepdims=True) + EPS)
    return (y * g.astype(jnp.float32)).astype(x.dtype)


def layernorm(x, g, b):
    xf = x.astype(jnp.float32)
    mu = jnp.mean(xf, axis=-1, keepdims=True)
    var = jnp.mean(jnp.square(xf - mu), axis=-1, keepdims=True)
    y = (xf - mu) * lax.rsqrt(var + EPS)
    return (y * g.astype(jnp.float32) + b.astype(jnp.float32)).astype(x.dtype)


def modulate(x, shift, scale):
    return x * (1 + scale) + shift


def split_cols(p):
    out, start = [], 0
    for w in IN_SPLITS:
        out.append(p[..., start:start + w])
        start += w
    return out


def rope_1d(x, pos):
    half = x.shape[-1] // 2
    inv = ROPE_BASE ** (-jnp.arange(half, dtype=jnp.float32) / half)
    ang = pos.astype(jnp.float32)[:, None] * inv[None, :]
    cos = jnp.cos(ang)[None, :, None, None, :].astype(x.dtype)
    sin = jnp.sin(ang)[None, :, None, None, :].astype(x.dtype)
    x1, x2 = x[..., :half], x[..., half:]
    return jnp.concatenate([x1 * cos - x2 * sin, x2 * cos + x1 * sin], axis=-1)


def axial_rope(x, rows, cols):
    r = ATT_DH // 2
    return jnp.concatenate([rope_1d(x[..., :r], rows), rope_1d(x[..., r:], cols)], axis=-1)


def diff_attention(q, k, v, lam):
    B, T = q.shape[0], q.shape[1]
    nb = T // ATT_QBLOCK
    qb = q.reshape(B, nb, ATT_QBLOCK, ATT_HEADS, 2, ATT_DH).transpose(1, 0, 2, 3, 4, 5)
    scale = ATT_DH ** -0.5

    def block(qi):
        s = jnp.einsum('bqhid,bkhid->bhiqk', qi, k).astype(jnp.float32) * scale
        p = jax.nn.softmax(s, axis=-1)
        w = (p[:, :, 0] - lam * p[:, :, 1]).astype(v.dtype)
        return jnp.einsum('bhqk,bkhv->bqhv', w, v)

    o = lax.map(block, qb)
    return o.transpose(1, 0, 2, 3, 4).reshape(B, T, ATT_HEADS, ATT_DV)


def spatial_gating(u, v, ln_g, ln_b, w_s, b_s):
    B, T, _ = v.shape
    n = T // GM_CHUNK
    dg = GM_WIDTH // GM_GROUPS
    vn = layernorm(v, ln_g, ln_b).reshape(B, n, GM_CHUNK, GM_GROUPS, dg)
    s = jnp.einsum('gts,bnsgc->bntgc', w_s, vn) + b_s.T[None, None, :, :, None]
    return u * s.reshape(B, T, GM_WIDTH)


def hgrn2_gates(z, lb):
    B, T, _ = z.shape
    zf = z.astype(jnp.float32)
    logf = jnp.logaddexp(jnp.log(lb), jnp.log1p(-lb) + jax.nn.log_sigmoid(zf))
    k = ((1 - lb) * jax.nn.sigmoid(-zf)).astype(z.dtype)
    return logf.reshape(B, T, HG_HEADS, HG_DK), k.reshape(B, T, HG_HEADS, HG_DK)


def hgrn2_scan(k, v, logf, s0, q=None):
    B, T = k.shape[0], k.shape[1]
    nc = T // HG_CHUNK
    with_output = q is not None

    def to_chunks(a):
        return a.reshape(B, nc, HG_CHUNK, a.shape[2], a.shape[3]).transpose(1, 0, 3, 2, 4)

    tri = jnp.tril(jnp.ones((HG_CHUNK, HG_CHUNK), dtype=bool))
    xs = (to_chunks(k), to_chunks(v), to_chunks(logf)) + ((to_chunks(q),) if with_output else ())

    def step(S, inp):
        k_, v_, lf = inp[0], inp[1], inp[2]
        A = jnp.cumsum(lf, axis=2)
        A_last = A[:, :, -1:, :]
        S_new = jnp.exp(A_last[:, :, 0, :])[..., None] * S + jnp.einsum(
            'bhsk,bhsv->bhkv', k_ * jnp.exp(A_last - A), v_)
        if not with_output:
            return S_new, None
        q_ = inp[3]
        o_inter = jnp.einsum('bhtk,bhkv->bhtv', q_ * jnp.exp(A), S)
        diff = A[:, :, :, None, :] - A[:, :, None, :, :]
        decay = jnp.exp(jnp.where(tri[None, None, :, :, None], diff, -jnp.inf))
        scores = jnp.einsum('bhtk,bhsk,bhtsk->bhts', q_, k_, decay)
        return S_new, o_inter + jnp.einsum('bhts,bhsv->bhtv', scores, v_)

    S, o = lax.scan(step, s0, xs)
    if with_output:
        o = o.transpose(1, 0, 3, 2, 4).reshape(B, T, HG_HEADS, HG_DV)
    return S, o


def flip(a):
    return jnp.flip(a, axis=1)


def branch_merge(y_att, y_gm, y_hg, gates, w_br_att, w_br_gm, w_br_hg, w_out):
    g_att, g_gm, g_hg = jnp.split(jax.nn.sigmoid(gates), N_BRANCH, axis=-1)
    y = g_att * (y_att @ w_br_att) + g_gm * (y_gm @ w_br_gm) + g_hg * (y_hg @ w_br_hg)
    return y @ w_out


def token_mixers(h, hc, rows, cols, lam_init, lb, with_ctx_out, w_in, lam_q1, lam_k1, lam_q2, lam_k2,
                 att_subln_g, gm_ln_g, gm_ln_b, gm_ws, gm_bs, hg_norm_g, w_br_att, w_br_gm, w_br_hg, w_out):
    B, T, _ = h.shape
    L = hc.shape[1]
    aq, ak, av, gu, gv, hq, hff, hfb, hi, hg, gates = split_cols(h @ w_in)
    caq, cak, cav, cgu, cgv, chq, chff, chfb, chi, chg, cgates = split_cols(hc @ w_in)

    lam = (jnp.exp(jnp.sum(lam_q1.astype(jnp.float32) * lam_k1.astype(jnp.float32)))
           - jnp.exp(jnp.sum(lam_q2.astype(jnp.float32) * lam_k2.astype(jnp.float32))) + lam_init)
    q = axial_rope(aq.reshape(B, T, ATT_HEADS, 2, ATT_DH), rows, cols)
    k = axial_rope(ak.reshape(B, T, ATT_HEADS, 2, ATT_DH), rows, cols)
    kc = cak.reshape(B, L, ATT_HEADS, 2, ATT_DH)
    vc = cav.reshape(B, L, ATT_HEADS, ATT_DV)
    keys = jnp.concatenate([k, kc], axis=1)
    vals = jnp.concatenate([av.reshape(B, T, ATT_HEADS, ATT_DV), vc], axis=1)

    def att_out(o):
        return (rmsnorm(o, att_subln_g) * (1 - lam_init)).reshape(o.shape[0], o.shape[1], ATT_VW)

    y_att = att_out(diff_attention(q, keys, vals, lam))

    y_gm = spatial_gating(jax.nn.gelu(gu), jax.nn.gelu(gv), gm_ln_g, gm_ln_b, gm_ws, gm_bs)

    lf_f, k_f = hgrn2_gates(hff, lb[0])
    lf_b, k_b = hgrn2_gates(hfb, lb[1])
    clf_f, ck_f = hgrn2_gates(chff, lb[0])
    clf_b, ck_b = hgrn2_gates(chfb, lb[1])
    qh = jax.nn.silu(hq).reshape(B, T, HG_HEADS, HG_DK)
    iv = hi.reshape(B, T, HG_HEADS, HG_DV)
    civ = chi.reshape(B, L, HG_HEADS, HG_DV)
    s0 = jnp.zeros((B, HG_HEADS, HG_DK, HG_DV), jnp.float32)
    cq = jax.nn.silu(chq).reshape(B, L, HG_HEADS, HG_DK) if with_ctx_out else None
    s_f, oc_f = hgrn2_scan(ck_f, civ, clf_f, s0, q=cq)
    s_b, oc_b = hgrn2_scan(flip(ck_b), flip(civ), flip(clf_b), s0, q=None if cq is None else flip(cq))
    _, o_f = hgrn2_scan(k_f, iv, lf_f, s_f, q=qh)
    _, o_b = hgrn2_scan(flip(k_b), flip(iv), flip(lf_b), s_b, q=flip(qh))

    def hg_out(o, g):
        Bo, To = o.shape[0], o.shape[1]
        o = rmsnorm(o.astype(h.dtype), hg_norm_g) * jax.nn.silu(g.reshape(Bo, To, HG_HEADS, HG_DV))
        return o.reshape(Bo, To, HG_VW)

    y_hg = hg_out(o_f + flip(o_b), hg)
    y = branch_merge(y_att, y_gm, y_hg, gates, w_br_att, w_br_gm, w_br_hg, w_out)

    if not with_ctx_out:
        return y, None
    yc_att = att_out(diff_attention(cak.reshape(B, L, ATT_HEADS, 2, ATT_DH) * 0 + caq.reshape(B, L, ATT_HEADS, 2, ATT_DH), kc, vc, lam))
    yc_gm = spatial_gating(jax.nn.gelu(cgu), jax.nn.gelu(cgv), gm_ln_g, gm_ln_b, gm_ws, gm_bs)
    yc_hg = hg_out(oc_f + flip(oc_b), chg)
    yc = branch_merge(yc_att, yc_gm, yc_hg, cgates, w_br_att, w_br_gm, w_br_hg, w_out)
    return y, yc


def conv_ffn(h, w_up, conv_w, conv_b, w_down):
    T = h.shape[1]
    u = h @ w_up
    pad = CONV_W // 2
    up = jnp.pad(u, ((0, 0), (pad, pad), (0, 0)))
    u = sum(up[:, j:j + T] * conv_w[j] for j in range(CONV_W)) + conv_b
    a, b = jnp.split(u, 2, axis=-1)
    return (jax.nn.silu(a) * b) @ w_down


def setup_inputs(seed: int = 0) -> dict:
    key = jax.random.key(seed)
    ks = jax.random.split(key, 32)
    D = D_MODEL

    def nrm(k, shape, s):
        return jax.random.normal(k, shape, jnp.float32) * s

    return {
        "x": nrm(ks[0], (BATCH, SEQ, D), 1.0),
        "c": nrm(ks[1], (BATCH, D), 1.0),
        "ctx": nrm(ks[2], (BATCH, CTX_LEN, D), 1.0),
        "c_ctx": nrm(ks[3], (D,), 1.0),
        "w_ada": nrm(ks[4], (DEPTH, D, 6 * D), 0.5 * D ** -0.5),
        "b_ada": nrm(ks[5], (DEPTH, 6 * D), 0.01),
        "g_pre_mix": 1.0 + nrm(ks[6], (DEPTH, D), 0.02),
        "g_post_mix": 1.0 + nrm(ks[7], (DEPTH, D), 0.02),
        "g_pre_ffn": 1.0 + nrm(ks[8], (DEPTH, D), 0.02),
        "g_post_ffn": 1.0 + nrm(ks[9], (DEPTH, D), 0.02),
        "w_in": nrm(ks[10], (DEPTH, D, IN_W), D ** -0.5),
        "lam_q1": nrm(ks[11], (DEPTH, ATT_DH), 0.1),
        "lam_k1": nrm(ks[12], (DEPTH, ATT_DH), 0.1),
        "lam_q2": nrm(ks[13], (DEPTH, ATT_DH), 0.1),
        "lam_k2": nrm(ks[14], (DEPTH, ATT_DH), 0.1),
        "att_subln_g": 1.0 + nrm(ks[15], (DEPTH, ATT_DV), 0.02),
        "gm_ln_g": 1.0 + nrm(ks[16], (DEPTH, GM_WIDTH), 0.02),
        "gm_ln_b": nrm(ks[17], (DEPTH, GM_WIDTH), 0.01),
        "gm_ws": nrm(ks[18], (DEPTH, GM_GROUPS, GM_CHUNK, GM_CHUNK), GM_CHUNK ** -0.5),
        "gm_bs": 1.0 + nrm(ks[19], (DEPTH, GM_GROUPS, GM_CHUNK), 0.01),
        "hg_lb": nrm(ks[20], (DEPTH, 2, HG_KW), 0.5),
        "hg_norm_g": 1.0 + nrm(ks[21], (DEPTH, HG_DV), 0.02),
        "w_br_att": nrm(ks[22], (DEPTH, ATT_VW, D), ATT_VW ** -0.5),
        "w_br_gm": nrm(ks[23], (DEPTH, GM_WIDTH, D), GM_WIDTH ** -0.5),
        "w_br_hg": nrm(ks[24], (DEPTH, HG_VW, D), HG_VW ** -0.5),
        "w_out": nrm(ks[25], (DEPTH, D, D), D ** -0.5),
        "w_up": nrm(ks[26], (DEPTH, D, 2 * D_FF), D ** -0.5),
        "conv_w": nrm(ks[27], (DEPTH, CONV_W, 2 * D_FF), 0.5),
        "conv_b": nrm(ks[28], (DEPTH, 2 * D_FF), 0.01),
        "w_down": nrm(ks[29], (DEPTH, D_FF, D), D_FF ** -0.5),
    }


def reference(x, c, ctx, c_ctx, w_ada, b_ada, g_pre_mix, g_post_mix, g_pre_ffn, g_post_ffn, w_in,
              lam_q1, lam_k1, lam_q2, lam_k2, att_subln_g, gm_ln_g, gm_ln_b, gm_ws, gm_bs, hg_lb,
              hg_norm_g, w_br_att, w_br_gm, w_br_hg, w_out, w_up, conv_w, conv_b, w_down):
    T = x.shape[1]
    ROWS = T // GRID_W
    rows = jnp.repeat(jnp.arange(ROWS, dtype=jnp.int32), GRID_W)
    cols = jnp.tile(jnp.arange(GRID_W, dtype=jnp.int32), ROWS)
    lb_all = jnp.cumsum(jax.nn.softmax(hg_lb.astype(jnp.float32), axis=0), axis=0)
    lb_all = lb_all - lb_all[0]
    xc = ctx
    for l in range(DEPTH):
        last = l == DEPTH - 1
        lam_init = 0.8 - 0.6 * math.exp(-0.3 * l)
        mod = (jax.nn.silu(c) @ w_ada[l] + b_ada[l])[:, None, :]
        modc = (jax.nn.silu(c_ctx) @ w_ada[l] + b_ada[l])[None, None, :]
        sh1, sc1, gt1, sh2, sc2, gt2 = jnp.split(mod, 6, axis=-1)
        csh1, csc1, cgt1, csh2, csc2, cgt2 = jnp.split(modc, 6, axis=-1)

        h = modulate(rmsnorm(x, g_pre_mix[l]), sh1, sc1)
        hc = modulate(rmsnorm(xc, g_pre_mix[l]), csh1, csc1)
        y, yc = token_mixers(h, hc, rows, cols, lam_init, lb_all[l], not last, w_in[l],
                             lam_q1[l], lam_k1[l], lam_q2[l], lam_k2[l], att_subln_g[l],
                             gm_ln_g[l], gm_ln_b[l], gm_ws[l], gm_bs[l], hg_norm_g[l],
                             w_br_att[l], w_br_gm[l], w_br_hg[l], w_out[l])
        x = x + gt1 * rmsnorm(y, g_post_mix[l])
        h = modulate(rmsnorm(x, g_pre_ffn[l]), sh2, sc2)
        x = x + gt2 * rmsnorm(conv_ffn(h, w_up[l], conv_w[l], conv_b[l], w_down[l]), g_post_ffn[l])
        if not last:
            xc = xc + cgt1 * rmsnorm(yc, g_post_mix[l])
            hc = modulate(rmsnorm(xc, g_pre_ffn[l]), csh2, csc2)
            xc = xc + cgt2 * rmsnorm(conv_ffn(hc, w_up[l], conv_w[l], conv_b[l], w_down[l]), g_post_ffn[l])
    return x
```

```cpp
#include <hip/hip_runtime.h>
#include <hip/hip_cooperative_groups.h>
#include <cstdio>
#include <cstdint>
namespace cg = cooperative_groups;

#define DI __device__ __forceinline__
#define LAS __attribute__((address_space(3)))
typedef unsigned short bf16_t;
typedef short bf16x8 __attribute__((ext_vector_type(8)));
typedef short s16x4 __attribute__((ext_vector_type(4)));
typedef float f32x4 __attribute__((ext_vector_type(4)));
typedef float f32x16 __attribute__((ext_vector_type(16)));
typedef unsigned u32x4 __attribute__((ext_vector_type(4)));
typedef unsigned u32x2 __attribute__((ext_vector_type(2)));
typedef float f32x2_t __attribute__((ext_vector_type(2)));
typedef __bf16 bf16x2_t __attribute__((ext_vector_type(2)));
DI unsigned cvtpk(float lo, float hi) { f32x2_t v = {lo, hi}; bf16x2_t b = __builtin_convertvector(v, bf16x2_t); return __builtin_bit_cast(unsigned, b); }
DI float bf2f(unsigned short u) { return __uint_as_float(((unsigned)u) << 16); }
DI float bflo(unsigned w) { return __uint_as_float(w << 16); }
DI float bfhi(unsigned w) { return __uint_as_float(w & 0xffff0000u); }
DI unsigned short f2bf(float f) { return (unsigned short)(cvtpk(f, 0.f) & 0xffffu); }
#define MFMA32(a, b, c) __builtin_amdgcn_mfma_f32_32x32x16_bf16((a), (b), (c), 0, 0, 0)
DI int opaque_tid() { int t = threadIdx.x; asm volatile("" : "+v"(t)); return t; }
DI int crow(int reg, int h) { return (reg & 3) + 8 * (reg >> 2) + 4 * h; }

constexpr int D = 1024, NB = 8, TL = 4096, LC = 256, TP = TL + LC, M = NB * TP;
constexpr int DFF = 2816, DFFH = 1408;
constexpr float EPS = 1e-6f;
constexpr float QSCALE = 0.125f * 1.4426950408889634f;
constexpr size_t MiB = (size_t)1 << 20;
constexpr size_t SLAB = (size_t)M * D * 2;
constexpr size_t TAB_MOD = 0;
constexpr size_t TAB_ROPE = 448 * 1024;
constexpr size_t TAB_LB = 460 * 1024;
constexpr size_t TAB_LAM = 480 * 1024;
constexpr size_t WS_BAR = 1024 * 1024;
constexpr size_t WS_WIN = 2 * MiB, WS_WBR = 28 * MiB, WS_WOUT = 34 * MiB, WS_WUP = 36 * MiB, WS_WDN = 47 * MiB;
constexpr size_t WS_XC = 53 * MiB, WS_SL = 62 * MiB, WS_END = WS_SL + SLAB * 13 / 2;
constexpr int NWAVES = 8, NTHR = 512;
constexpr int PMQ = 24;
constexpr int LDS_BYTES = 147456;
#define WG_BLOCKED() ((int)__builtin_amdgcn_readfirstlane((int)((volatile LAS unsigned*)(lds + LDS_BYTES - 64))[4]))
#define WG_INTER()   ((int)__builtin_amdgcn_readfirstlane((int)((volatile LAS unsigned*)(lds + LDS_BYTES - 64))[5]))

namespace pg8 {
constexpr int BM = 256, BK = 64, HALF = 128, HTB = HALF * BK * 2, STAGE_BYTES = 8 * HTB, NXCD = 8, WGM = 8;
DI int lds_byte(int r, int c) { const int st = (r >> 4) * 2 + (c >> 5), rr = r & 15, cc = c & 31, ob = rr * 64 + cc * 2; return st * 1024 + (ob ^ (((ob >> 9) & 1) << 5)); }
DI void stage_rc(int b, int& R, int& C) { const int st = b / 1024, sb = b % 1024, swz = sb ^ (((sb >> 9) & 1) << 5); R = (st >> 1) * 16 + swz / 64; C = (st & 1) * 32 + (swz % 64) / 2; }
DI int perm32(int rho) { const int n = rho >> 4, i = rho & 15; return 8 * (i >> 2) + 4 * n + (i & 3); }
struct Unit { int pm, pn, sub; const char* a; const char* b; };
struct TileOrder {
    int nM, nN, nwg, G, c;
    DI void init(int nM_, int nN_, int G_, int c_) { nM = nM_; nN = nN_; nwg = nM * nN; G = G_; c = c_; }
    DI bool get(long L, int& pm, int& pn) const {
        if (L >= nwg) return false;
        int wgid = (int)L; { const int q = nwg / NXCD, r = nwg % NXCD, xcd = wgid % NXCD, off = wgid / NXCD; wgid = (xcd < r ? xcd * (q + 1) : r * (q + 1) + (xcd - r) * q) + off; }
        const int nig = WGM * nN, gid = wgid / nig, fm = gid * WGM, gsz = (nM - fm) < WGM ? (nM - fm) : WGM;
        pm = fm + ((wgid % nig) % gsz); pn = (wgid % nig) / gsz; return true;
    }
};
template <class Epi, class Sched>
DI void gemm_phase(LAS unsigned char* lds, const int K, const Sched& S, const Epi& E) {
    const int tid = opaque_tid(), wid = __builtin_amdgcn_readfirstlane(tid >> 6), lane = tid & 63, wr = wid >> 2, wc = wid & 3, fr = lane & 15, fq = lane >> 4;
    const int nt = K / BK;
    unsigned voffA[2], voffB[2];
#pragma unroll
    for (int i = 0; i < 2; ++i) { int R, C; stage_rc(tid * 16 + i * 8192, R, C); const int Rb = (R & ~31) + perm32(R & 31);
        voffA[i] = (unsigned)(R * K + C) * 2u; voffB[i] = (unsigned)(Rb * K + C) * 2u; }
    const size_t kstep = (size_t)(BK * 2);
    const size_t hstep = (size_t)HALF * K * 2;
    const unsigned ldsw = (unsigned)wid * 1024u;
    const int aoff = lds_byte(wr * 64 + fr, fq * 8), boff = lds_byte(wc * 32 + fr, fq * 8);
#define PG8_SA(b, h) (((b) * 2 + (h)) * HTB)
#define PG8_SB(b, h) ((4 + (b) * 2 + (h)) * HTB)
#define PG8_STAGE(bufoff, gbase, voff) do { _Pragma("unroll") for (int _i = 0; _i < 2; ++_i) \
        __builtin_amdgcn_global_load_lds((const unsigned*)((const char*)(gbase) + (voff)[_i]), (LAS unsigned*)(lds + (bufoff) + ldsw + _i * 8192), 16, 0, 0); } while (0)
#define PG8_LDA(dst, b, h) do { _Pragma("unroll") for (int m = 0; m < 4; ++m) _Pragma("unroll") for (int k = 0; k < 2; ++k) dst[m][k] = *(const LAS bf16x8*)(lds + PG8_SA(b, h) + aoff + m * 2048 + k * 1024); } while (0)
#define PG8_LDB(dst, b, h) do { _Pragma("unroll") for (int n = 0; n < 2; ++n) _Pragma("unroll") for (int k = 0; k < 2; ++k) dst[n][k] = *(const LAS bf16x8*)(lds + PG8_SB(b, h) + boff + n * 2048 + k * 1024); } while (0)
#define PG8_MMA(ai, bj, At, Bt) do { __builtin_amdgcn_s_setprio(1); _Pragma("unroll") for (int m = 0; m < 4; ++m) _Pragma("unroll") for (int n = 0; n < 2; ++n) _Pragma("unroll") for (int k = 0; k < 2; ++k) \
        acc[ai][bj][m][n] = __builtin_amdgcn_mfma_f32_16x16x32_bf16(Bt[n][k], At[m][k], acc[ai][bj][m][n], 0, 0, 0); __builtin_amdgcn_s_setprio(0); } while (0)
#define PG8_WAIT_V(n) asm volatile("s_waitcnt vmcnt(" #n ")" ::: "memory")
#define PG8_WAIT_L(n) asm volatile("s_waitcnt lgkmcnt(" #n ")" ::: "memory")
#define PG8_BAR __builtin_amdgcn_s_barrier()
#define PG8_SCHED __builtin_amdgcn_sched_barrier(0)
    Unit cur, nxt; int ui = 0;
    if (!S.next(0, cur)) return;
    f32x4 acc[2][2][4][2];
#pragma unroll
    for (int a = 0; a < 2; ++a)
#pragma unroll
        for (int b = 0; b < 2; ++b)
#pragma unroll
            for (int m = 0; m < 4; ++m)
#pragma unroll
                for (int n = 0; n < 2; ++n) acc[a][b][m][n] = (f32x4){0.f, 0.f, 0.f, 0.f};
    bf16x8 At[4][2], B0[2][2], B1[2][2];
    const char* cA = cur.a; const char* cB = cur.b;
    PG8_STAGE(PG8_SB(0, 0), cB, voffB); PG8_STAGE(PG8_SB(0, 1), cB + hstep, voffB); PG8_STAGE(PG8_SA(0, 0), cA, voffA); PG8_STAGE(PG8_SA(0, 1), cA + hstep, voffA);
    if (wr == 1) PG8_BAR;
    PG8_WAIT_V(2); PG8_BAR;
    PG8_STAGE(PG8_SB(1, 0), cB + kstep, voffB); PG8_STAGE(PG8_SA(1, 0), cA + kstep, voffA); PG8_STAGE(PG8_SB(1, 1), cB + hstep + kstep, voffB);
    PG8_WAIT_V(6); PG8_BAR;
    for (;;) {
        const bool has_next = S.next(ui + 1, nxt);
        const char* nA = has_next ? nxt.a : cA; const char* nB = has_next ? nxt.b : cB;
        for (int t = 0; t < nt; t += 2) {
            const bool last = (t == nt - 2);
            const char* a1 = cA + (size_t)(t + 1) * kstep;
            const char* a2 = last ? nA : cA + (size_t)(t + 2) * kstep; const char* b2 = last ? nB : cB + (size_t)(t + 2) * kstep;
            const char* a3 = a2 + kstep; const char* b3 = b2 + kstep;
            PG8_LDB(B0, 0, 0); PG8_LDB(B1, 0, 1); PG8_SCHED; PG8_LDA(At, 0, 0); PG8_STAGE(PG8_SA(1, 1), a1 + hstep, voffA);
            PG8_WAIT_V(8); PG8_WAIT_L(0); PG8_BAR; PG8_MMA(0, 0, At, B0); PG8_MMA(0, 1, At, B1); PG8_BAR; PG8_SCHED;
            PG8_LDA(At, 0, 1); PG8_STAGE(PG8_SB(0, 0), b2, voffB); PG8_STAGE(PG8_SB(0, 1), b2 + hstep, voffB); PG8_STAGE(PG8_SA(0, 0), a2, voffA);
            PG8_WAIT_V(8); PG8_WAIT_L(0); PG8_BAR; PG8_MMA(1, 0, At, B0); PG8_MMA(1, 1, At, B1); PG8_BAR; PG8_SCHED;
            PG8_LDB(B0, 1, 0); PG8_LDB(B1, 1, 1); PG8_SCHED; PG8_LDA(At, 1, 0); PG8_STAGE(PG8_SA(0, 1), a2 + hstep, voffA);
            PG8_WAIT_V(8); PG8_WAIT_L(0); PG8_BAR; PG8_MMA(0, 0, At, B0); PG8_MMA(0, 1, At, B1); PG8_BAR; PG8_SCHED;
            PG8_LDA(At, 1, 1); PG8_STAGE(PG8_SB(1, 0), b3, voffB); PG8_STAGE(PG8_SB(1, 1), b3 + hstep, voffB); PG8_STAGE(PG8_SA(1, 0), a3, voffA);
            PG8_WAIT_V(8); PG8_WAIT_L(0); PG8_BAR; PG8_MMA(1, 0, At, B0); PG8_MMA(1, 1, At, B1); PG8_BAR; PG8_SCHED;
        }
        if (wr == 0) PG8_BAR;
        { int efr = fr, efq = fq; asm volatile("" : "+v"(efr), "+v"(efq)); E(acc, cur, wr, wc, efr, efq); }
        if (!has_next) break;
#pragma unroll
        for (int a = 0; a < 2; ++a)
#pragma unroll
            for (int b = 0; b < 2; ++b)
#pragma unroll
                for (int m = 0; m < 4; ++m)
#pragma unroll
                    for (int n = 0; n < 2; ++n) acc[a][b][m][n] = (f32x4){0.f, 0.f, 0.f, 0.f};
        cur = nxt; cA = nA; cB = nB; ++ui;
        if (wr == 1) PG8_BAR;
    }
    PG8_WAIT_V(0);
    PG8_BAR;
#undef PG8_SA
#undef PG8_SB
#undef PG8_STAGE
#undef PG8_LDA
#undef PG8_LDB
#undef PG8_MMA
#undef PG8_WAIT_V
#undef PG8_WAIT_L
#undef PG8_BAR
#undef PG8_SCHED
}
}
typedef f32x4 AccT[2][2][4][2];

struct SchedG {
    pg8::TileOrder o; const char* A; const char* B; size_t tstep; int skipctx;
    DI bool next(int i, pg8::Unit& u) const {
        int pm, pn; if (!o.get((long)i * o.G + o.c, pm, pn)) return false;
        if (skipctx) pm += pm >> 4;
        u.pm = pm; u.pn = pn; u.sub = 0; u.a = A + (size_t)pm * tstep; u.b = B + (size_t)pn * tstep; return true;
    }
};
struct SchedHG {
    pg8::TileOrder o; const char* A; const char* B; size_t tstep; int extra, qextra;
    DI bool next(int i, pg8::Unit& u) const {
        const long L = (long)i * o.G + o.c; int pm, pn, pb;
        if (L < o.nwg) { o.get(L, pm, pn); pb = pn; }
        else if (L < o.nwg + extra) { const int j = (int)(L - o.nwg); pm = 17 * (j >> 2) + 16; pn = 16 + (j & 3); pb = pn; }
        else if (L < o.nwg + extra + qextra) { const int j = (int)(L - o.nwg - extra); pm = j >> 2; pn = 100 + (j & 3); pb = 20 + (j & 3); }
        else return false;
        u.pm = pm; u.pn = pn; u.sub = 0; u.a = A + (size_t)pm * tstep; u.b = B + (size_t)pb * tstep; return true;
    }
};
struct SchedATQ {
    pg8::TileOrder o; const char* A; const char* B; size_t tstep; int qfirst;
    DI bool next(int i, pg8::Unit& u) const {
        const long L = (long)i * o.G + o.c; int pm, pn;
        if (L < o.nwg) { o.get(L, pm, pn); pn += 4; }
        else { const int j = (int)(L - o.nwg); pm = qfirst + (j >> 2); pn = j & 3; if (pm >= 136) return false; }
        u.pm = pm; u.pn = pn; u.sub = 0; u.a = A + (size_t)pm * tstep; u.b = B + (size_t)pn * tstep; return true;
    }
};
struct SchedM {
    pg8::TileOrder o; const char* ws; int skipctx;
    DI bool next(int i, pg8::Unit& u) const {
        const int ti = i / 6, sub = i - ti * 6;
        int pm, pn; if (!o.get((long)ti * o.G + o.c, pm, pn)) return false;
        if (skipctx) pm += pm >> 4;
        const int j = sub >> 1; const size_t tstep = (size_t)256 * D * 2;
        u.pm = pm; u.pn = pn; u.sub = sub;
        if (sub & 1) { const size_t yo = (j == 0) ? 2 * SLAB : (j == 1 ? 3 * SLAB : 1 * SLAB); u.a = ws + WS_SL + yo + (size_t)pm * tstep; u.b = ws + WS_WBR + (size_t)j * (2 * MiB) + (size_t)pn * tstep; }
        else { u.a = ws + WS_SL + (size_t)pm * tstep; u.b = ws + WS_WIN + (size_t)10240 * D * 2 + (size_t)j * (2 * MiB) + (size_t)pn * tstep; }
        return true;
    }
};

DI float silu_f(float v) { return v * __builtin_amdgcn_rcpf(1.f + __builtin_amdgcn_exp2f(-1.4426950408889634f * v)); }
DI float gelu_f(float v) { const float z = (-1.5957691216f * 1.4426950408889634f) * (v + 0.044715f * v * v * v); return v * __builtin_amdgcn_rcpf(1.f + __builtin_amdgcn_exp2f(z)); }
DI float sigm_f(float v) { return __builtin_amdgcn_rcpf(1.f + __builtin_amdgcn_exp2f(-1.4426950408889634f * v)); }
DI float logf_gate(float z, float lbv) {
    const float sg = __builtin_amdgcn_rcpf(1.f + __builtin_amdgcn_exp2f(-1.4426950408889634f * z));
    const float f = fmaxf(lbv + (1.f - lbv) * sg, 1e-30f);
    return 0.6931471805599453f * __builtin_amdgcn_logf(f);
}
template <int TYPE>
DI void epi_apply(const AccT& acc, const pg8::Unit& u, int ct, int wr, int wc, int fr, int fq, bf16_t* dst, const float* lbp, const float* rope, float* rstat = nullptr) {
    const int row0 = u.pm * 256 + wr * 64 + fr; const int c0 = ct * 256 + wc * 32 + 8 * fq;
    const bool isctx = ((u.pm % 17) == 16);
    f32x4 lbq[2][2];
    if (TYPE == 3) {
#pragma unroll
        for (int bj = 0; bj < 2; ++bj) { lbq[bj][0] = *(const f32x4*)(lbp + c0 + bj * 128); lbq[bj][1] = *(const f32x4*)(lbp + c0 + bj * 128 + 4); }
    }
#pragma unroll
    for (int ai = 0; ai < 2; ++ai) {
      f32x4 csq[4], snq[4];
      if (TYPE == 4 || TYPE == 5) {
#pragma unroll
          for (int q = 0; q < 4; ++q) { csq[q] = (f32x4){1.f, 1.f, 1.f, 1.f}; snq[q] = (f32x4){0.f, 0.f, 0.f, 0.f}; }
          if (!isctx) {
#pragma unroll
              for (int q = 0; q < 4; ++q) { const int row = row0 + ai * 128 + q * 16; const int p = row - (u.pm / 17) * TP; const int pos = (wc & 1) ? (p & 63) : (p >> 6);
                  csq[q] = *(const f32x4*)(rope + pos * 16 + 4 * fq); snq[q] = *(const f32x4*)(rope + 1024 + pos * 16 + 4 * fq); }
          }
      }
#pragma unroll
        for (int m = 0; m < 4; ++m) {
            const int row = row0 + ai * 128 + m * 16;
            bf16_t* rowp = dst + (size_t)row * D + c0;
            float rs_ = 0.f, rq_ = 0.f;
            f32x4 cs = {1.f, 1.f, 1.f, 1.f}, sn = {0.f, 0.f, 0.f, 0.f};
            if (TYPE == 4 || TYPE == 5) { cs = csq[m]; sn = snq[m]; }
#pragma unroll
            for (int bj = 0; bj < 2; ++bj) {
                f32x4 v0 = acc[ai][bj][m][0], v1 = acc[ai][bj][m][1];
                if (TYPE == 1) {
#pragma unroll
                    for (int i = 0; i < 4; ++i) { v0[i] = silu_f(v0[i]); v1[i] = silu_f(v1[i]); }
                } else if (TYPE == 2 || TYPE == 6) {
#pragma unroll
                    for (int i = 0; i < 4; ++i) { v0[i] = gelu_f(v0[i]); v1[i] = gelu_f(v1[i]); }
                    if (TYPE == 6) {
#pragma unroll
                        for (int i = 0; i < 4; ++i) { rs_ += v0[i] + v1[i]; rq_ += v0[i] * v0[i] + v1[i] * v1[i]; }
                    }
                } else if (TYPE == 3) {
                    const f32x4 lb0 = lbq[bj][0], lb1 = lbq[bj][1];
#pragma unroll
                    for (int i = 0; i < 4; ++i) { v0[i] = logf_gate(v0[i], lb0[i]); v1[i] = logf_gate(v1[i], lb1[i]); }
                } else if (TYPE == 4 || TYPE == 5) {
                    const f32x4 o0 = v0 * cs - v1 * sn, o1 = v1 * cs + v0 * sn;
                    v0 = o0; v1 = o1;
                    if (TYPE == 4) { v0 = v0 * QSCALE; v1 = v1 * QSCALE; }
                }
                u32x4 w; w.x = cvtpk(v0[0], v0[1]); w.y = cvtpk(v0[2], v0[3]); w.z = cvtpk(v1[0], v1[1]); w.w = cvtpk(v1[2], v1[3]);
                *(u32x4*)(rowp + bj * 128) = w;
                __builtin_amdgcn_sched_barrier(0);
            }
            if (TYPE == 6) {
                rs_ += __shfl_xor(rs_, 16); rs_ += __shfl_xor(rs_, 32); rq_ += __shfl_xor(rq_, 16); rq_ += __shfl_xor(rq_, 32);
                if (fq == 0) { f32x2_t* sp_ = (f32x2_t*)(rstat + ((size_t)row * 16 + ct * 4 + wc) * 2); *sp_ = (f32x2_t){rs_, rq_}; }
            }
        }
    }
}
struct EpiIn {
    unsigned char* sl; int stage; const float* lb; const float* rope;
    DI void operator()(const AccT& acc, const pg8::Unit& u, int wr, int wc, int fr, int fq) const {
        const int blk = u.pn >> 2, ct = u.pn & 3;
        if (stage == 3) { epi_apply<1>(acc, u, ct, wr, wc, fr, fq, (bf16_t*)(sl + 5 * SLAB), nullptr, nullptr); return; }
        if (stage == 0) {
            if (u.pn >= 100) { epi_apply<4>(acc, u, u.pn - 100, wr, wc, fr, fq, (bf16_t*)(sl + 6 * SLAB), nullptr, rope); return; }
            if (blk == 0) epi_apply<1>(acc, u, ct, wr, wc, fr, fq, (bf16_t*)(sl + 1 * SLAB), nullptr, nullptr);
            else if (blk == 1) epi_apply<3>(acc, u, ct, wr, wc, fr, fq, (bf16_t*)(sl + 2 * SLAB), lb, nullptr);
            else if (blk == 2) epi_apply<3>(acc, u, ct, wr, wc, fr, fq, (bf16_t*)(sl + 3 * SLAB), lb + 1024, nullptr);
            else if (blk == 3) epi_apply<0>(acc, u, ct, wr, wc, fr, fq, (bf16_t*)(sl + 4 * SLAB), nullptr, nullptr);
            else epi_apply<1>(acc, u, ct, wr, wc, fr, fq, (bf16_t*)(sl + 5 * SLAB), nullptr, nullptr);
        } else if (stage == 1) {
            if (blk == 0) epi_apply<4>(acc, u, ct, wr, wc, fr, fq, (bf16_t*)(sl + 2 * SLAB), nullptr, rope);
            else if (blk == 1) epi_apply<5>(acc, u, ct, wr, wc, fr, fq, (bf16_t*)(sl + 3 * SLAB), nullptr, rope);
            else epi_apply<0>(acc, u, ct, wr, wc, fr, fq, (bf16_t*)(sl + 4 * SLAB), nullptr, nullptr);
        } else {
            if (blk == 0) epi_apply<2>(acc, u, ct, wr, wc, fr, fq, (bf16_t*)(sl + 3 * SLAB), nullptr, nullptr);
            else epi_apply<6>(acc, u, ct, wr, wc, fr, fq, (bf16_t*)(sl + 4 * SLAB), nullptr, nullptr, (float*)(sl + 5 * SLAB));
        }
    }
};
struct EpiF32 {
    float* Y; int ldc;
    DI void operator()(const AccT& acc, const pg8::Unit& u, int wr, int wc, int fr, int fq) const {
        const int row0 = u.pm * 256 + wr * 64 + fr; const int c0 = u.pn * 256 + wc * 32 + 8 * fq;
#pragma unroll
        for (int ai = 0; ai < 2; ++ai)
#pragma unroll
            for (int m = 0; m < 4; ++m) { float* rowp = Y + (size_t)(row0 + ai * 128 + m * 16) * ldc + c0;
#pragma unroll
                for (int bj = 0; bj < 2; ++bj) { *(f32x4*)(rowp + bj * 128) = acc[ai][bj][m][0]; *(f32x4*)(rowp + bj * 128 + 4) = acc[ai][bj][m][1]; } }
    }
};
struct EpiB16 {
    bf16_t* O; int ldc;
    DI void operator()(const AccT& acc, const pg8::Unit& u, int wr, int wc, int fr, int fq) const {
        const int row0 = u.pm * 256 + wr * 64 + fr; const int c0 = u.pn * 256 + wc * 32 + 8 * fq;
#pragma unroll
        for (int ai = 0; ai < 2; ++ai)
#pragma unroll
            for (int m = 0; m < 4; ++m) { bf16_t* rowp = O + (size_t)(row0 + ai * 128 + m * 16) * ldc + c0;
#pragma unroll
                for (int bj = 0; bj < 2; ++bj) { const f32x4 v0 = acc[ai][bj][m][0], v1 = acc[ai][bj][m][1];
                    u32x4 w; w.x = cvtpk(v0[0], v0[1]); w.y = cvtpk(v0[2], v0[3]); w.z = cvtpk(v1[0], v1[1]); w.w = cvtpk(v1[2], v1[3]);
                    *(u32x4*)(rowp + bj * 128) = w; } }
    }
};
struct EpiMerge {
    unsigned char* scr;
    bf16_t* Ys;
    DI void operator()(const AccT& acc, const pg8::Unit& u, int wr, int wc, int fr, int fq) const {
        const int tid = opaque_tid();
        unsigned char* gsc = scr; unsigned char* ysc = scr + 16 * 512 * 16; unsigned to = (unsigned)tid * 16u; asm volatile("" : "+v"(to));
        const int sub = u.sub;
        if ((sub & 1) == 0) {
#pragma unroll
            for (int ai = 0; ai < 2; ++ai)
#pragma unroll
                for (int bj = 0; bj < 2; ++bj)
#pragma unroll
                    for (int m = 0; m < 4; ++m) { const f32x4 v0 = acc[ai][bj][m][0], v1 = acc[ai][bj][m][1];
                        u32x4 w; w.x = cvtpk(sigm_f(v0[0]), sigm_f(v0[1])); w.y = cvtpk(sigm_f(v0[2]), sigm_f(v0[3])); w.z = cvtpk(sigm_f(v1[0]), sigm_f(v1[1])); w.w = cvtpk(sigm_f(v1[2]), sigm_f(v1[3]));
                        *(u32x4*)(gsc + ((ai * 2 + bj) * 4 + m) * 8192 + to) = w; __builtin_amdgcn_sched_barrier(0); }
        } else {
            const int row0 = u.pm * 256 + wr * 64 + fr; const int c0 = u.pn * 256 + wc * 32 + 8 * fq;
#pragma unroll
            for (int ai = 0; ai < 2; ++ai)
#pragma unroll
                for (int bj = 0; bj < 2; ++bj) {
                    u32x4 g[4], ys[4];
#pragma unroll
                    for (int m = 0; m < 4; ++m) { const int e = (ai * 2 + bj) * 4 + m; g[m] = *(const u32x4*)(gsc + e * 8192 + to);
                        ys[m] = (sub > 1) ? *(const u32x4*)(ysc + e * 8192 + to) : (u32x4){0u, 0u, 0u, 0u}; }
#pragma unroll
                    for (int m = 0; m < 4; ++m) { const int e = (ai * 2 + bj) * 4 + m;
                        f32x4 y0 = acc[ai][bj][m][0], y1 = acc[ai][bj][m][1];
                        y0[0] = y0[0] * bflo(g[m].x) + bflo(ys[m].x); y0[1] = y0[1] * bfhi(g[m].x) + bfhi(ys[m].x); y0[2] = y0[2] * bflo(g[m].y) + bflo(ys[m].y); y0[3] = y0[3] * bfhi(g[m].y) + bfhi(ys[m].y);
                        y1[0] = y1[0] * bflo(g[m].z) + bflo(ys[m].z); y1[1] = y1[1] * bfhi(g[m].z) + bfhi(ys[m].z); y1[2] = y1[2] * bflo(g[m].w) + bflo(ys[m].w); y1[3] = y1[3] * bfhi(g[m].w) + bfhi(ys[m].w);
                        u32x4 w; w.x = cvtpk(y0[0], y0[1]); w.y = cvtpk(y0[2], y0[3]); w.z = cvtpk(y1[0], y1[1]); w.w = cvtpk(y1[2], y1[3]);
                        if (sub < 5) *(u32x4*)(ysc + e * 8192 + to) = w;
                        else *(u32x4*)(Ys + (size_t)(row0 + ai * 128 + m * 16) * D + c0 + bj * 128) = w; }
                    __builtin_amdgcn_sched_barrier(0);
                }
        }
    }
};

DI float wave_sum(float v) {
#pragma unroll
    for (int o = 1; o < 64; o <<= 1) v += __shfl_xor(v, o);
    return v;
}
struct Ptrs {
    const float *x, *c, *ctx, *c_ctx, *w_ada, *b_ada, *g_pre_mix, *g_post_mix, *g_pre_ffn, *g_post_ffn, *w_in, *lam_q1, *lam_k1, *lam_q2, *lam_k2,
        *att_subln_g, *gm_ln_g, *gm_ln_b, *gm_ws, *gm_bs, *hg_lb, *hg_norm_g, *w_br_att, *w_br_gm, *w_br_hg, *w_out, *w_up, *conv_w, *conv_b, *w_down;
    float* out; unsigned char* ws;
};

DI const void* karg_load(int off) {
    const volatile __attribute__((address_space(4))) unsigned long long* p = (const volatile __attribute__((address_space(4))) unsigned long long*)((const __attribute__((address_space(4))) char*)__builtin_amdgcn_kernarg_segment_ptr() + off);
    return (const void*)(*p);
}
#define KP(name) ((const float*)karg_load((int)__builtin_offsetof(Ptrs, name)))
#define KWS() ((unsigned char*)karg_load((int)__builtin_offsetof(Ptrs, ws)))
#define KOUT() ((float*)karg_load((int)__builtin_offsetof(Ptrs, out)))

DI void transpose_item(const float* W, int K, int Nsrc, int src0, bf16_t* WT, int dst0, int k0, bool perm, LAS float* scr, int lane) {
    { float wv[32];
#pragma unroll
      for (int i = 0; i < 32; ++i) wv[i] = W[(size_t)(k0 + 2 * i + (lane >> 5)) * Nsrc + src0 + (lane & 31)];
#pragma unroll
      for (int i = 0; i < 32; ++i) scr[(2 * i + (lane >> 5)) * 33 + (lane & 31)] = wv[i]; }
    asm volatile("s_waitcnt lgkmcnt(0)" ::: "memory");
    const int c = lane & 7;
#pragma unroll
    for (int j = 0; j < 4; ++j) { const int n = (lane >> 3) + 8 * j;
        int ns = n; if (perm) { const int f = n >> 3, i = n & 7; ns = 4 * f + (i & 3) + 16 * (i >> 2); }
        const LAS float* s = scr + (8 * c) * 33 + ns;
        u32x4 o; o.x = cvtpk(s[0 * 33], s[1 * 33]); o.y = cvtpk(s[2 * 33], s[3 * 33]); o.z = cvtpk(s[4 * 33], s[5 * 33]); o.w = cvtpk(s[6 * 33], s[7 * 33]);
        *(u32x4*)(WT + (size_t)(dst0 + n) * K + k0 + 8 * c) = o; }
    asm volatile("s_waitcnt lgkmcnt(0)" ::: "memory");
}
DI void convert_weights(int l, LAS unsigned char* lds, int NGW) {
    const int tid = opaque_tid(), lane = tid & 63, wave = __builtin_amdgcn_readfirstlane(tid >> 6); const int gw = blockIdx.x * NWAVES + wave;
    LAS float* scr = (LAS float*)(lds + wave * 16384);
    unsigned char* ws = KWS();
    constexpr int I_IN = 416 * 16, I_BR = 32 * 16, I_UP = 176 * 16, I_DN = 32 * 44;
    constexpr int NIT = I_IN + 4 * I_BR + I_UP + I_DN;
    for (int it = gw; it < NIT; it += NGW) {
        int r = it;
        if (r < I_IN) { const int kb = r / 416, nb = r % 416; const int db = nb >> 5;
            const int sb = (db < 5) ? (5 + db) : (db < 10 ? (db - 5) : db);
            transpose_item(KP(w_in) + (size_t)l * D * 13312, D, 13312, sb * 1024 + (nb & 31) * 32, (bf16_t*)(ws + WS_WIN), nb * 32, kb * 64, (db == 5 || db == 6), scr, lane); continue; }
        r -= I_IN;
        if (r < 4 * I_BR) { const int j = r / I_BR, rr = r % I_BR; const int kb = rr / 32, nb = rr % 32;
            const float* W = (j == 0 ? KP(w_br_att) : j == 1 ? KP(w_br_gm) : j == 2 ? KP(w_br_hg) : KP(w_out)) + (size_t)l * D * D;
            bf16_t* dst = (bf16_t*)(ws + (j < 3 ? WS_WBR + (size_t)j * 2 * MiB : WS_WOUT));
            transpose_item(W, D, D, nb * 32, dst, nb * 32, kb * 64, false, scr, lane); continue; }
        r -= 4 * I_BR;
        if (r < I_UP) { const int kb = r / 176, nb = r % 176; const int j0 = nb * 32; const int hf = j0 / DFF, jj = j0 % DFF;
            const int src = (jj < DFFH) ? (DFFH * hf + jj) : (DFF + DFFH * hf + (jj - DFFH));
            transpose_item(KP(w_up) + (size_t)l * D * 2 * DFF, D, 2 * DFF, src, (bf16_t*)(ws + WS_WUP), j0, kb * 64, false, scr, lane); continue; }
        r -= I_UP;
        { const int kb = r / 32, nb = r % 32;
          transpose_item(KP(w_down) + (size_t)l * DFF * D, DFF, D, nb * 32, (bf16_t*)(ws + WS_WDN), nb * 32, kb * 64, false, scr, lane); }
    }
}

struct RW {
    const float* xin_lat; const float* xin_ctx; float* xo_lat; float* xo_ctx;
    const bf16_t* Y; const float* g_post; const float* modA; int gate_chunk;
    const float* g_pre; const float* modB; int sh_chunk; bf16_t* H; int skipctx;
};
DI void rw_phase(const RW& a, int NGW) {
    const int tid = opaque_tid(), lane = tid & 63; const int gw = blockIdx.x * NWAVES + __builtin_amdgcn_readfirstlane(tid >> 6);
    int r = gw;
    if (a.skipctx) { while (r < M && (r % TP) >= TL) r += NGW; }
    f32x4 xn[4], yn[4];
#define RW_LOAD(rr) do { const int b_ = (rr) / TP, p_ = (rr) - b_ * TP; const bool c_ = p_ >= TL; const size_t xo_ = c_ ? (size_t)(b_ * LC + p_ - TL) * D : (size_t)(b_ * TL + p_) * D; \
        const float* xi_ = (c_ ? a.xin_ctx : a.xin_lat) + xo_; _Pragma("unroll") for (int j = 0; j < 4; ++j) xn[j] = *(const f32x4*)(xi_ + 4 * lane + 256 * j); \
        if (a.Y) { const bf16_t* yr_ = a.Y + (size_t)(rr) * D; _Pragma("unroll") for (int j = 0; j < 4; ++j) { const u32x2 w_ = *(const u32x2*)(yr_ + 4 * lane + 256 * j); yn[j] = (f32x4){bflo(w_.x), bfhi(w_.x), bflo(w_.y), bfhi(w_.y)}; } } } while (0)
    if (r < M) RW_LOAD(r);
    f32x4 gpo[4], gpr[4];
#pragma unroll
    for (int j = 0; j < 4; ++j) { gpo[j] = a.Y ? *(const f32x4*)(a.g_post + 4 * lane + 256 * j) : (f32x4){0.f, 0.f, 0.f, 0.f}; gpr[j] = a.H ? *(const f32x4*)(a.g_pre + 4 * lane + 256 * j) : (f32x4){0.f, 0.f, 0.f, 0.f}; }
    while (r < M) {
        const int b = r / TP, p = r - b * TP; const bool isctx = p >= TL;
        const size_t xoff = isctx ? (size_t)(b * LC + p - TL) * D : (size_t)(b * TL + p) * D;
        const int mr = isctx ? 8 : b;
        f32x4 x[4], y[4];
#pragma unroll
        for (int j = 0; j < 4; ++j) { x[j] = xn[j]; y[j] = yn[j]; }
        int rn = r + NGW;
        if (a.skipctx) { while (rn < M && (rn % TP) >= TL) rn += NGW; }
        if (rn < M) RW_LOAD(rn);
        f32x4 gq[4], s1q[4], s2q[4];
        if (a.Y) { const float* gt = a.modA + (size_t)mr * 6144 + a.gate_chunk * 1024;
#pragma unroll
            for (int j = 0; j < 4; ++j) gq[j] = *(const f32x4*)(gt + 4 * lane + 256 * j); }
        if (a.H) { const float* sh = a.modB + (size_t)mr * 6144 + a.sh_chunk * 1024;
#pragma unroll
            for (int j = 0; j < 4; ++j) { s1q[j] = *(const f32x4*)(sh + 4 * lane + 256 * j); s2q[j] = *(const f32x4*)(sh + 1024 + 4 * lane + 256 * j); } }
        if (a.Y) {
            float ss = 0.f;
#pragma unroll
            for (int j = 0; j < 4; ++j) ss += (y[j][0] * y[j][0] + y[j][1] * y[j][1]) + (y[j][2] * y[j][2] + y[j][3] * y[j][3]);
            const float rs = rsqrtf(wave_sum(ss) * (1.f / D) + EPS);
            float* xo = (isctx ? a.xo_ctx : a.xo_lat) + xoff;
#pragma unroll
            for (int j = 0; j < 4; ++j) { x[j] = x[j] + gq[j] * (y[j] * rs * gpo[j]); *(f32x4*)(xo + 4 * lane + 256 * j) = x[j]; }
        }
        if (a.H) {
            float ss = 0.f;
#pragma unroll
            for (int j = 0; j < 4; ++j) ss += (x[j][0] * x[j][0] + x[j][1] * x[j][1]) + (x[j][2] * x[j][2] + x[j][3] * x[j][3]);
            const float rs = rsqrtf(wave_sum(ss) * (1.f / D) + EPS);
            bf16_t* hr = a.H + (size_t)r * D;
#pragma unroll
            for (int j = 0; j < 4; ++j) { const f32x4 h = (x[j] * rs * gpr[j]) * (s2q[j] + 1.f) + s1q[j];
                u32x2 w; w.x = cvtpk(h[0], h[1]); w.y = cvtpk(h[2], h[3]); *(u32x2*)(hr + 4 * lane + 256 * j) = w; }
        }
        r = rn;
    }
#undef RW_LOAD
}

DI void p0_tables(LAS unsigned char* lds) {
    const int tid = opaque_tid();
    unsigned char* ws0 = KWS(); float* mod = (float*)(ws0 + TAB_MOD);
    const float* pc = KP(c); const float* pcc = KP(c_ctx); const float* pwa = KP(w_ada); const float* pba = KP(b_ada);
    LAS float* sc = (LAS float*)lds;
    LAS float* part = (LAS float*)(lds + 40960);
    for (int it = blockIdx.x; it < 192; it += gridDim.x) {
        const int l = it / 96, n0 = (it % 96) * 64;
        __syncthreads();
        for (int i = tid; i < 9 * 1024; i += NTHR) { const int r = i >> 10, k = i & 1023; const float v = (r < 8) ? pc[r * 1024 + k] : pcc[k]; sc[i] = v / (1.f + __expf(-v)); }
        __syncthreads();
        const int col = tid & 63, ks = tid >> 6;
        float a[9];
#pragma unroll
        for (int r = 0; r < 9; ++r) a[r] = 0.f;
        const float* w = pwa + (size_t)l * D * 6144 + n0 + col;
        for (int k0 = ks * 128; k0 < ks * 128 + 128; k0 += 16) { float wv[16];
#pragma unroll
            for (int j = 0; j < 16; ++j) wv[j] = w[(size_t)(k0 + j) * 6144];
#pragma unroll
            for (int j = 0; j < 16; ++j)
#pragma unroll
                for (int r = 0; r < 9; ++r) a[r] += sc[r * 1024 + k0 + j] * wv[j]; }
#pragma unroll
        for (int r = 0; r < 9; ++r) part[(ks * 9 + r) * 64 + col] = a[r];
        __syncthreads();
        for (int i = tid; i < 576; i += NTHR) { const int r = i >> 6, cc = i & 63; float s = 0.f;
#pragma unroll
            for (int q = 0; q < 8; ++q) s += part[(q * 9 + r) * 64 + cc];
            mod[((size_t)l * 9 + r) * 6144 + n0 + cc] = s + pba[l * 6144 + n0 + cc]; }
    }
    if (blockIdx.x == gridDim.x - 1) {
        float* rope = (float*)(ws0 + TAB_ROPE); float* lb = (float*)(ws0 + TAB_LB); float* lam = (float*)(ws0 + TAB_LAM);
        const float* phl = KP(hg_lb); const float* q1 = KP(lam_q1); const float* k1 = KP(lam_k1); const float* q2 = KP(lam_q2); const float* k2 = KP(lam_k2);
        for (int i = tid; i < 1024; i += NTHR) { const int pos = i >> 4, f = i & 15; const float inv = exp2f(-(float)f * (13.287712379549449f / 16.f)); const float ang = (float)pos * inv;
            rope[i] = cosf(ang); rope[1024 + i] = sinf(ang); }
        for (int i = tid; i < 2048; i += NTHR) { lb[i] = 0.f; const float l0 = phl[i], l1 = phl[2048 + i]; lb[2048 + i] = 1.f / (1.f + expf(l0 - l1)); }
        if (tid < 2) { const int l = tid; float s1 = 0.f, s2 = 0.f; for (int i = 0; i < 64; ++i) { s1 += q1[l * 64 + i] * k1[l * 64 + i]; s2 += q2[l * 64 + i] * k2[l * 64 + i]; }
            const float li = 0.8f - 0.6f * expf(-0.3f * (float)l); lam[l] = expf(s1) - expf(s2) + li; lam[2 + l] = li; }
    }
}

constexpr int SC_QH = 0, SC_KH = 17408, SC_KT = 34816, SC_VT = 53248, SC_ST = 71680, SC_VEC = 106496, SC_QT = 108032;
DI void scan_phase(unsigned char* sl, int layer, bool ctx_out, bool do_store, LAS unsigned char* lds) {
    const int wg = blockIdx.x; if (wg >= 128) return;
    const int tid = opaque_tid(), lane = tid & 63, wid = __builtin_amdgcn_readfirstlane(tid >> 6), r32 = lane & 31, hh = lane >> 5;
    const int dir = wg & 1, h = (wg >> 1) & 7, b = wg >> 4;
    const bf16_t* Qs = (const bf16_t*)(sl + 1 * SLAB); bf16_t* Gs = (bf16_t*)(sl + (size_t)(2 + dir) * SLAB); const bf16_t* Vs = (const bf16_t*)(sl + 4 * SLAB);
    const int kp = tid & 63, oct = tid >> 6;
    const size_t colp = (size_t)h * 128 + 2 * kp;
    f32x16 sacc[2];
#pragma unroll
    for (int t = 0; t < 2; ++t)
#pragma unroll
        for (int i = 0; i < 16; ++i) sacc[t][i] = 0.f;
    const int vb = wid & 3, kb0 = 2 * (wid >> 2), tb = wid >> 2;
    LAS float* vec = (LAS float*)(lds + SC_VEC); LAS float* qt = (LAS float*)(lds + SC_QT);
#define SC_ROW0(ci_) (((ci_) < 4) ? (b * TP + TL + 64 * (dir ? 3 - (ci_) : (ci_))) : (b * TP + 64 * (dir ? 63 - ((ci_) - 4) : ((ci_) - 4))))
#define SC_LOAD(r0_) do { _Pragma("unroll") for (int j = 0; j < 8; ++j) { const int tau = 8 * oct + j; const size_t ro = (size_t)((r0_) + (dir ? 63 - tau : tau)) * D + colp; \
            lw[j] = *(const unsigned*)(Gs + ro); qw[j] = *(const unsigned*)(Qs + ro); vw[j] = *(const unsigned*)(Vs + ro); } } while (0)
    unsigned lw[8], qw[8], vw[8];
    SC_LOAD(SC_ROW0(0));
    for (int ci = 0; ci < 68; ++ci) {
        const int row0 = SC_ROW0(ci); const bool need_out = (ci < 4) ? ctx_out : true;
        float c0 = 0.f, c1 = 0.f; float A0[8], A1[8];
#pragma unroll
        for (int j = 0; j < 8; ++j) { c0 += bflo(lw[j]); c1 += bfhi(lw[j]); A0[j] = c0; A1[j] = c1; }
        *(LAS f32x2_t*)(qt + oct * 128 + 2 * kp) = (f32x2_t){c0, c1};
        __syncthreads();
        float of0 = 0.f, of1 = 0.f, ar0 = 0.f, ar1 = 0.f, al0 = 0.f, al1 = 0.f;
#pragma unroll
        for (int o = 0; o < 8; ++o) { const f32x2_t tq = *(const LAS f32x2_t*)(qt + o * 128 + 2 * kp);
            if (o < oct) { of0 += tq.x; of1 += tq.y; } if (o < 4) { ar0 += tq.x; ar1 += tq.y; } al0 += tq.x; al1 += tq.y; }
        if (oct == 0) { *(LAS f32x2_t*)(vec + 2 * kp) = (f32x2_t){__expf(ar0), __expf(ar1)}; *(LAS f32x2_t*)(vec + 128 + 2 * kp) = (f32x2_t){__expf(al0), __expf(al1)};
            *(LAS f32x2_t*)(vec + 256 + 2 * kp) = (f32x2_t){__expf(al0 - ar0), __expf(al1 - ar1)}; }
        unsigned kt0[4], kt1[4];
        float kprev0 = 0.f, kprev1 = 0.f;
#pragma unroll
        for (int j = 0; j < 8; ++j) {
            const float a0 = of0 + A0[j], a1 = of1 + A1[j];
            const float l0 = bflo(lw[j]), l1 = bfhi(lw[j]);
            const float qh0 = bflo(qw[j]) * __expf(fminf(a0 - ar0, 80.f)), qh1 = bfhi(qw[j]) * __expf(fminf(a1 - ar1, 80.f));
            const float kh0 = (1.f - __expf(l0)) * __expf(fminf(ar0 - a0, 80.f)), kh1 = (1.f - __expf(l1)) * __expf(fminf(ar1 - a1, 80.f));
            const int tau = 8 * oct + j;
            *(LAS unsigned*)(lds + SC_QH + tau * 272 + kp * 4) = cvtpk(qh0, qh1);
            *(LAS unsigned*)(lds + SC_KH + tau * 272 + kp * 4) = cvtpk(kh0, kh1);
            if (j & 1) { kt0[j >> 1] = cvtpk(kprev0, kh0); kt1[j >> 1] = cvtpk(kprev1, kh1); } else { kprev0 = kh0; kprev1 = kh1; }
        }
        *(LAS u32x4*)(lds + SC_KT + (2 * kp) * 144 + oct * 16) = (u32x4){kt0[0], kt0[1], kt0[2], kt0[3]};
        *(LAS u32x4*)(lds + SC_KT + (2 * kp + 1) * 144 + oct * 16) = (u32x4){kt1[0], kt1[1], kt1[2], kt1[3]};
        { u32x4 v0, v1;
#pragma unroll
          for (int e = 0; e < 4; ++e) { v0[e] = (vw[2 * e] & 0xffffu) | (vw[2 * e + 1] << 16); v1[e] = (vw[2 * e] >> 16) | (vw[2 * e + 1] & 0xffff0000u); }
          *(LAS u32x4*)(lds + SC_VT + (2 * kp) * 144 + oct * 16) = v0; *(LAS u32x4*)(lds + SC_VT + (2 * kp + 1) * 144 + oct * 16) = v1; }
        if (ci + 1 < 68) SC_LOAD(SC_ROW0(ci + 1));
        __syncthreads();
#pragma unroll
        for (int t = 0; t < 2; ++t)
#pragma unroll
            for (int g = 0; g < 4; ++g) { const int k0 = 32 * (kb0 + t) + 8 * g + 4 * hh; const f32x4 ea = *(const LAS f32x4*)(vec + k0);
                u32x2 w; w.x = cvtpk(sacc[t][4 * g] * ea[0], sacc[t][4 * g + 1] * ea[1]); w.y = cvtpk(sacc[t][4 * g + 2] * ea[2], sacc[t][4 * g + 3] * ea[3]);
                *(LAS u32x2*)(lds + SC_ST + (32 * vb + r32) * 272 + k0 * 2) = w; }
        __syncthreads();
        f32x16 d1[2];
#pragma unroll
        for (int t = 0; t < 2; ++t) {
#pragma unroll
            for (int i = 0; i < 16; ++i) d1[t][i] = 0.f;
#pragma unroll
            for (int s = 0; s < 4; ++s) { const bf16x8 af = *(const LAS bf16x8*)(lds + SC_KT + (32 * (kb0 + t) + r32) * 144 + (16 * s + 8 * hh) * 2);
                const bf16x8 bfv = *(const LAS bf16x8*)(lds + SC_VT + (32 * vb + r32) * 144 + (16 * s + 8 * hh) * 2);
                d1[t] = MFMA32(af, bfv, d1[t]); }
        }
        if (need_out) {
            f32x16 o, p0, p1;
#pragma unroll
            for (int i = 0; i < 16; ++i) { o[i] = 0.f; p0[i] = 0.f; p1[i] = 0.f; }
            bf16x8 qf[8];
#pragma unroll
            for (int s = 0; s < 8; ++s) qf[s] = *(const LAS bf16x8*)(lds + SC_QH + (32 * tb + r32) * 272 + (16 * s + 8 * hh) * 2);
            if (tb == 1) {
#pragma unroll
                for (int s = 0; s < 8; ++s) { const bf16x8 sf = *(const LAS bf16x8*)(lds + SC_ST + (32 * vb + r32) * 272 + (16 * s + 8 * hh) * 2);
                    const bf16x8 k0 = *(const LAS bf16x8*)(lds + SC_KH + r32 * 272 + (16 * s + 8 * hh) * 2), k1 = *(const LAS bf16x8*)(lds + SC_KH + (32 + r32) * 272 + (16 * s + 8 * hh) * 2);
                    o = MFMA32(sf, qf[s], o); p0 = MFMA32(k0, qf[s], p0); p1 = MFMA32(k1, qf[s], p1); }
#pragma unroll
                for (int i = 0; i < 16; ++i) if (crow(i, hh) > r32) p1[i] = 0.f;
            } else {
#pragma unroll
                for (int s = 0; s < 8; ++s) { const bf16x8 sf = *(const LAS bf16x8*)(lds + SC_ST + (32 * vb + r32) * 272 + (16 * s + 8 * hh) * 2);
                    const bf16x8 k0 = *(const LAS bf16x8*)(lds + SC_KH + r32 * 272 + (16 * s + 8 * hh) * 2);
                    o = MFMA32(sf, qf[s], o); p0 = MFMA32(k0, qf[s], p0); }
#pragma unroll
                for (int i = 0; i < 16; ++i) if (crow(i, hh) > r32) p0[i] = 0.f;
            }
#define SC_PV(PT, SB) do { _Pragma("unroll") for (int s = 0; s < 2; ++s) { \
                    u32x4 pa; pa.x = cvtpk(PT[8 * s], PT[8 * s + 1]); pa.y = cvtpk(PT[8 * s + 2], PT[8 * s + 3]); pa.z = cvtpk(PT[8 * s + 4], PT[8 * s + 5]); pa.w = cvtpk(PT[8 * s + 6], PT[8 * s + 7]); \
                    const u32x2 lo = *(const LAS u32x2*)(lds + SC_VT + (32 * vb + r32) * 144 + (32 * (SB) + 16 * s + 4 * hh) * 2); \
                    const u32x2 hi = *(const LAS u32x2*)(lds + SC_VT + (32 * vb + r32) * 144 + (32 * (SB) + 16 * s + 8 + 4 * hh) * 2); \
                    const u32x4 vbv = {lo.x, lo.y, hi.x, hi.y}; \
                    o = MFMA32(__builtin_bit_cast(bf16x8, vbv), __builtin_bit_cast(bf16x8, pa), o); } } while (0)
            SC_PV(p0, 0);
            if (tb == 1) SC_PV(p1, 1);
#undef SC_PV
            { const int tau = 32 * tb + r32; const size_t ro = (size_t)(row0 + (dir ? 63 - tau : tau)) * D + h * 128 + 32 * vb + 4 * hh;
#pragma unroll
              for (int g4 = 0; g4 < 4; ++g4) { u32x2 w; w.x = cvtpk(o[4 * g4], o[4 * g4 + 1]); w.y = cvtpk(o[4 * g4 + 2], o[4 * g4 + 3]);
                  if (do_store) *(u32x2*)(Gs + ro + 8 * g4) = w; } }
        }
#pragma unroll
        for (int t = 0; t < 2; ++t)
#pragma unroll
            for (int g = 0; g < 4; ++g) { const int k0 = 32 * (kb0 + t) + 8 * g + 4 * hh; const f32x4 aS = *(const LAS f32x4*)(vec + 128 + k0), bS = *(const LAS f32x4*)(vec + 256 + k0);
#pragma unroll
                for (int e = 0; e < 4; ++e) sacc[t][4 * g + e] = aS[e] * sacc[t][4 * g + e] + bS[e] * d1[t][4 * g + e]; }
        __syncthreads();
    }
}

DI void combine_phase(unsigned char* sl, const float* gnorm, bool skipctx, int NGW) {
    const int tid = opaque_tid(), lane = tid & 63; const int gw = blockIdx.x * NWAVES + __builtin_amdgcn_readfirstlane(tid >> 6);
    const bf16_t* Of = (const bf16_t*)(sl + 2 * SLAB); const bf16_t* Ob = (const bf16_t*)(sl + 3 * SLAB); const bf16_t* Hg = (const bf16_t*)(sl + 5 * SLAB); bf16_t* Y = (bf16_t*)(sl + 1 * SLAB);
    const int c16 = (lane & 7) * 16;
    float g[16];
#pragma unroll
    for (int i = 0; i < 16; ++i) g[i] = gnorm[c16 + i];
    int r = gw;
    if (skipctx) { while (r < M && (r % TP) >= TL) r += NGW; }
    u32x4 na0, na1, nb0, nb1, nh0, nh1;
#define CB_LOAD(rr) do { const size_t o_ = (size_t)(rr) * D + lane * 16; na0 = *(const u32x4*)(Of + o_); na1 = *(const u32x4*)(Of + o_ + 8); nb0 = *(const u32x4*)(Ob + o_); nb1 = *(const u32x4*)(Ob + o_ + 8); nh0 = *(const u32x4*)(Hg + o_); nh1 = *(const u32x4*)(Hg + o_ + 8); } while (0)
    if (r < M) CB_LOAD(r);
    while (r < M) {
        const size_t off = (size_t)r * D + lane * 16;
        const u32x4 a0 = na0, a1 = na1, b0 = nb0, b1 = nb1, h0 = nh0, h1 = nh1;
        int rn = r + NGW;
        if (skipctx) { while (rn < M && (rn % TP) >= TL) rn += NGW; }
        if (rn < M) CB_LOAD(rn);
        float o[16], hg[16];
#pragma unroll
        for (int i = 0; i < 4; ++i) { o[2 * i] = bflo(a0[i]) + bflo(b0[i]); o[2 * i + 1] = bfhi(a0[i]) + bfhi(b0[i]); o[8 + 2 * i] = bflo(a1[i]) + bflo(b1[i]); o[8 + 2 * i + 1] = bfhi(a1[i]) + bfhi(b1[i]);
            hg[2 * i] = bflo(h0[i]); hg[2 * i + 1] = bfhi(h0[i]); hg[8 + 2 * i] = bflo(h1[i]); hg[8 + 2 * i + 1] = bfhi(h1[i]); }
        float ss = 0.f;
#pragma unroll
        for (int i = 0; i < 16; ++i) ss += o[i] * o[i];
        ss += __shfl_xor(ss, 1); ss += __shfl_xor(ss, 2); ss += __shfl_xor(ss, 4);
        const float rs = rsqrtf(ss * (1.f / 128.f) + EPS);
        u32x4 w0, w1;
#pragma unroll
        for (int i = 0; i < 4; ++i) { w0[i] = cvtpk(o[2 * i] * rs * g[2 * i] * hg[2 * i], o[2 * i + 1] * rs * g[2 * i + 1] * hg[2 * i + 1]);
            w1[i] = cvtpk(o[8 + 2 * i] * rs * g[8 + 2 * i] * hg[8 + 2 * i], o[8 + 2 * i + 1] * rs * g[8 + 2 * i + 1] * hg[8 + 2 * i + 1]); }
        *(u32x4*)(Y + off) = w0; *(u32x4*)(Y + off + 8) = w1;
        r = rn;
    }
#undef CB_LOAD
}

constexpr int AT_KP = 144, AT_VP = 320, AT_KB = 2 * 64 * AT_KP, AT_BUF = AT_KB + 64 * AT_VP;
DI void attn_unit(const bf16_t* Q, const bf16_t* Kp, const bf16_t* Vp, bf16_t* O, size_t qrow0, size_t krow0, int ntile, int h, float lam, float lam_init, const float* gsub, LAS unsigned char* lds) {
    const int tid = opaque_tid(), lane = tid & 63, wid = __builtin_amdgcn_readfirstlane(tid >> 6), r32 = lane & 31, hh = lane >> 5;
    const int sub = wid & 1, qg = wid >> 1;
    constexpr int KRING = 0, VRING = 65536, SLOT = 16384;
    bf16x8 qf[4];
    { const bf16_t* qp = Q + (qrow0 + 32 * qg + r32) * D + h * 128 + sub * 64 + 8 * hh;
#pragma unroll
      for (int d0 = 0; d0 < 4; ++d0) qf[d0] = *(const bf16x8*)(qp + 16 * d0); }
    f32x16 ot[4];
#pragma unroll
    for (int d = 0; d < 4; ++d)
#pragma unroll
        for (int i = 0; i < 16; ++i) ot[d][i] = 0.f;
    float m_run = -1e30f, l_run = 0.f;
    const char* kbu = (const char*)(Kp + krow0 * D + h * 128); const char* vbu = (const char*)(Vp + krow0 * D + h * 128);
    unsigned kso, vso0, vso1;
    { const int kr = 8 * wid + (lane >> 3); const int kc = (lane & 7) ^ ((kr >> 1) & 7); kso = (unsigned)((kr * D + kc * 8) * 2);
      const int vr0 = 4 * wid + (lane >> 4), vr1 = vr0 + 32; const int vc = (lane & 15) ^ (4 * (vr0 & 3));
      vso0 = (unsigned)((vr0 * D + vc * 8) * 2); vso1 = (unsigned)((vr1 * D + vc * 8) * 2); }
    const unsigned ldsb = (unsigned)(unsigned long)lds;
#define AT_DMA(gp, ldsoff) do { unsigned keep_; const unsigned dst_ = (unsigned)__builtin_amdgcn_readfirstlane((int)(ldsb + (unsigned)(ldsoff))); \
        asm volatile("s_mov_b32 %0, m0\n\ts_mov_b32 m0, %2\n\ts_nop 0\n\tglobal_load_lds_dwordx4 %1, off\n\ts_mov_b32 m0, %0" : "=&s"(keep_) : "v"(gp), "s"(dst_) : "memory"); } while (0)
#define AT_ISSUE_K(tile, slot) do { const char* g_ = kbu + (size_t)(tile) * (64 * D * 2) + kso; AT_DMA(g_, KRING + (slot) * SLOT + wid * 1024); AT_DMA(g_ + 128, KRING + (slot) * SLOT + 8192 + wid * 1024); } while (0)
#define AT_ISSUE_V(tile, slot) do { const char* g_ = vbu + (size_t)(tile) * (64 * D * 2); AT_DMA(g_ + vso0, VRING + (slot) * SLOT + wid * 1024); AT_DMA(g_ + vso1, VRING + (slot) * SLOT + 8192 + wid * 1024); } while (0)
    asm volatile("s_waitcnt lgkmcnt(0)" ::: "memory"); __builtin_amdgcn_s_barrier();
    AT_ISSUE_K(0, 0); AT_ISSUE_K(1, 1); AT_ISSUE_K(2, 2); AT_ISSUE_K(3, 3); AT_ISSUE_V(0, 0); AT_ISSUE_V(1, 1);
    { const u32x4 z = {0u, 0u, 0u, 0u}; *(LAS u32x4*)(lds + VRING + 3 * SLOT + tid * 16) = z; *(LAS u32x4*)(lds + VRING + 3 * SLOT + 8192 + tid * 16) = z; }
    asm volatile("s_waitcnt vmcnt(0) lgkmcnt(0)" ::: "memory"); __builtin_amdgcn_s_barrier(); asm volatile("" ::: "memory");
    const int q4 = (lane & 15) >> 2, p4 = lane & 3, blk = (lane >> 4) & 1;
    const int ksw = (r32 >> 1) & 7;
    const int kro = sub * 8192 + r32 * 128;
    const int vro = (4 * hh + q4) * 256 + blk * 32 + p4 * 8;
    f32x16 sc[2], sn[2];
#pragma unroll
    for (int kh = 0; kh < 2; ++kh) {
#pragma unroll
        for (int i = 0; i < 16; ++i) sc[kh][i] = 0.f;
#pragma unroll
        for (int d0 = 0; d0 < 4; ++d0) { const bf16x8 kf = *(const LAS bf16x8*)(lds + KRING + kro + kh * 4096 + (((2 * d0 + hh) ^ ksw) * 16)); sc[kh] = MFMA32(kf, qf[d0], sc[kh]); }
    }
    u32x4 pp[4];
#pragma unroll
    for (int j = 0; j < 4; ++j) pp[j] = (u32x4){0u, 0u, 0u, 0u};
    constexpr float AT_TRIG = 16384.f;
    f32x16 negm;
    { float mx = fmaxf(fmaxf(sc[0][0], sc[0][1]), sc[0][2]);
#pragma unroll
      for (int i = 3; i < 15; i += 2) mx = fmaxf(fmaxf(mx, sc[0][i]), sc[0][i + 1]);
      mx = fmaxf(mx, sc[0][15]);
#pragma unroll
      for (int i = 0; i < 16; i += 2) mx = fmaxf(fmaxf(mx, sc[1][i]), sc[1][i + 1]);
      mx = fmaxf(mx, __shfl_xor(mx, 32));
#pragma unroll
      for (int i = 0; i < 16; ++i) { negm[i] = -mx; sc[0][i] -= mx; sc[1][i] -= mx; } }
    asm volatile("s_waitcnt lgkmcnt(0)" ::: "memory"); __builtin_amdgcn_s_barrier(); asm volatile("" ::: "memory");
    const bool shifted = wid >= 4;
    float ps = 0.f;
    if (shifted) {
#pragma unroll
        for (int kh = 0; kh < 2; ++kh)
#pragma unroll
            for (int i = 0; i < 16; ++i) { sc[kh][i] = __builtin_amdgcn_exp2f(sc[kh][i]); ps += sc[kh][i]; }
        l_run += ps;
    }
    int ks0 = 0, ks1 = 1, vsm1 = 3, vs1 = 2;
    for (int t = 0; t < ntile; t += 2) {
      {
        { const int tk = (t + 4 < ntile) ? t + 4 : ntile - 1; AT_ISSUE_K(tk, ks0); const int tv = (t + 2 < ntile) ? t + 2 : ntile - 1; AT_ISSUE_V(tv, vs1); }
        LAS unsigned char* kb = lds + KRING + ks1 * SLOT + kro;
        LAS unsigned char* vb = lds + VRING + vsm1 * SLOT + vro;
        __builtin_amdgcn_s_setprio(1);
        { bf16x8 ql[4];
#pragma unroll
          for (int d0 = 0; d0 < 4; ++d0) ql[d0] = qf[d0];
#pragma unroll
          for (int kh = 0; kh < 2; ++kh) {
            bf16x8 kf[4];
#pragma unroll
            for (int e = 0; e < 4; ++e) kf[e] = *(const LAS bf16x8*)(kb + kh * 4096 + (((2 * e + hh) ^ ksw) * 16));
            sn[kh] = MFMA32(kf[0], ql[0], negm);
#pragma unroll
            for (int d0 = 1; d0 < 4; ++d0) sn[kh] = MFMA32(kf[d0], ql[d0], sn[kh]);
            __builtin_amdgcn_sched_barrier(0);
          } }
#pragma unroll
        for (int j = 0; j < 4; ++j) {
            s16x4 lo[4], hi[4];
#pragma unroll
            for (int e = 0; e < 4; ++e) { LAS unsigned char* vp = vb + j * 4096 + ((e ^ q4) * 64);
                lo[e] = __builtin_bit_cast(s16x4, __builtin_amdgcn_ds_read_tr16_b64_v4i16((LAS s16x4*)vp));
                hi[e] = __builtin_bit_cast(s16x4, __builtin_amdgcn_ds_read_tr16_b64_v4i16((LAS s16x4*)(vp + 2048))); }
#pragma unroll
            for (int e = 0; e < 4; ++e) ot[e] = MFMA32(__builtin_shufflevector(lo[e], hi[e], 0, 1, 2, 3, 4, 5, 6, 7), __builtin_bit_cast(bf16x8, pp[j]), ot[e]);
            __builtin_amdgcn_sched_barrier(0);
        }
        __builtin_amdgcn_s_setprio(0);
        if (!shifted) {
            ps = 0.f;
#pragma unroll
            for (int kh = 0; kh < 2; ++kh)
#pragma unroll
                for (int i = 0; i < 16; ++i) { sc[kh][i] = __builtin_amdgcn_exp2f(sc[kh][i]); ps += sc[kh][i]; }
            l_run += ps;
        }
        if (__builtin_amdgcn_ballot_w64(ps > AT_TRIG) != 0ull) {
            float pm = fmaxf(fmaxf(sc[0][0], sc[0][1]), sc[0][2]);
#pragma unroll
            for (int i = 3; i < 15; i += 2) pm = fmaxf(fmaxf(pm, sc[0][i]), sc[0][i + 1]);
            pm = fmaxf(pm, sc[0][15]);
#pragma unroll
            for (int i = 0; i < 16; i += 2) pm = fmaxf(fmaxf(pm, sc[1][i]), sc[1][i + 1]);
            pm = fmaxf(pm, __shfl_xor(pm, 32));
            const bool mv = pm > 256.f; const float delta = mv ? __builtin_amdgcn_logf(pm) : 0.f; const float alpha = mv ? __builtin_amdgcn_rcpf(pm) : 1.f;
            l_run *= alpha;
#pragma unroll
            for (int i = 0; i < 16; ++i) negm[i] -= delta;
#pragma unroll
            for (int kh = 0; kh < 2; ++kh)
#pragma unroll
                for (int i = 0; i < 16; ++i) { sc[kh][i] *= alpha; sn[kh][i] -= delta; }
#pragma unroll
            for (int d = 0; d < 4; ++d)
#pragma unroll
                for (int i = 0; i < 16; ++i) ot[d][i] *= alpha;
        }
#pragma unroll
        for (int kh = 0; kh < 2; ++kh)
#pragma unroll
            for (int s2 = 0; s2 < 2; ++s2) { u32x4 pa; pa.x = cvtpk(sc[kh][8 * s2], sc[kh][8 * s2 + 1]); pa.y = cvtpk(sc[kh][8 * s2 + 2], sc[kh][8 * s2 + 3]); pa.z = cvtpk(sc[kh][8 * s2 + 4], sc[kh][8 * s2 + 5]); pa.w = cvtpk(sc[kh][8 * s2 + 6], sc[kh][8 * s2 + 7]);
                pp[2 * kh + s2] = pa; }
        { const int n0 = ks1; ks1 = (ks1 + 1) & 3; ks0 = n0; vsm1 = (vsm1 + 1) & 3; vs1 = (vs1 + 1) & 3; }
        asm volatile("s_waitcnt vmcnt(8) lgkmcnt(0)" ::: "memory"); __builtin_amdgcn_s_barrier(); asm volatile("" ::: "memory");
        if (shifted && t + 1 < ntile) {
            ps = 0.f;
#pragma unroll
            for (int kh = 0; kh < 2; ++kh)
#pragma unroll
                for (int i = 0; i < 16; ++i) { sn[kh][i] = __builtin_amdgcn_exp2f(sn[kh][i]); ps += sn[kh][i]; }
            l_run += ps;
        }
          }
      {
        const int t1 = t + 1;
        { const int tk = (t1 + 4 < ntile) ? t1 + 4 : ntile - 1; AT_ISSUE_K(tk, ks0); const int tv = (t1 + 2 < ntile) ? t1 + 2 : ntile - 1; AT_ISSUE_V(tv, vs1); }
        LAS unsigned char* kb = lds + KRING + ks1 * SLOT + kro;
        LAS unsigned char* vb = lds + VRING + vsm1 * SLOT + vro;
        __builtin_amdgcn_s_setprio(1);
        { bf16x8 ql[4];
#pragma unroll
          for (int d0 = 0; d0 < 4; ++d0) ql[d0] = qf[d0];
#pragma unroll
          for (int kh = 0; kh < 2; ++kh) {
            bf16x8 kf[4];
#pragma unroll
            for (int e = 0; e < 4; ++e) kf[e] = *(const LAS bf16x8*)(kb + kh * 4096 + (((2 * e + hh) ^ ksw) * 16));
            sc[kh] = MFMA32(kf[0], ql[0], negm);
#pragma unroll
            for (int d0 = 1; d0 < 4; ++d0) sc[kh] = MFMA32(kf[d0], ql[d0], sc[kh]);
            __builtin_amdgcn_sched_barrier(0);
          } }
#pragma unroll
        for (int j = 0; j < 4; ++j) {
            s16x4 lo[4], hi[4];
#pragma unroll
            for (int e = 0; e < 4; ++e) { LAS unsigned char* vp = vb + j * 4096 + ((e ^ q4) * 64);
                lo[e] = __builtin_bit_cast(s16x4, __builtin_amdgcn_ds_read_tr16_b64_v4i16((LAS s16x4*)vp));
                hi[e] = __builtin_bit_cast(s16x4, __builtin_amdgcn_ds_read_tr16_b64_v4i16((LAS s16x4*)(vp + 2048))); }
#pragma unroll
            for (int e = 0; e < 4; ++e) ot[e] = MFMA32(__builtin_shufflevector(lo[e], hi[e], 0, 1, 2, 3, 4, 5, 6, 7), __builtin_bit_cast(bf16x8, pp[j]), ot[e]);
            __builtin_amdgcn_sched_barrier(0);
        }
        __builtin_amdgcn_s_setprio(0);
        if (!shifted) {
            ps = 0.f;
#pragma unroll
            for (int kh = 0; kh < 2; ++kh)
#pragma unroll
                for (int i = 0; i < 16; ++i) { sn[kh][i] = __builtin_amdgcn_exp2f(sn[kh][i]); ps += sn[kh][i]; }
            l_run += ps;
        }
        if (__builtin_amdgcn_ballot_w64(ps > AT_TRIG) != 0ull) {
            float pm = fmaxf(fmaxf(sn[0][0], sn[0][1]), sn[0][2]);
#pragma unroll
            for (int i = 3; i < 15; i += 2) pm = fmaxf(fmaxf(pm, sn[0][i]), sn[0][i + 1]);
            pm = fmaxf(pm, sn[0][15]);
#pragma unroll
            for (int i = 0; i < 16; i += 2) pm = fmaxf(fmaxf(pm, sn[1][i]), sn[1][i + 1]);
            pm = fmaxf(pm, __shfl_xor(pm, 32));
            const bool mv = pm > 256.f; const float delta = mv ? __builtin_amdgcn_logf(pm) : 0.f; const float alpha = mv ? __builtin_amdgcn_rcpf(pm) : 1.f;
            l_run *= alpha;
#pragma unroll
            for (int i = 0; i < 16; ++i) negm[i] -= delta;
#pragma unroll
            for (int kh = 0; kh < 2; ++kh)
#pragma unroll
                for (int i = 0; i < 16; ++i) { sn[kh][i] *= alpha; sc[kh][i] -= delta; }
#pragma unroll
            for (int d = 0; d < 4; ++d)
#pragma unroll
                for (int i = 0; i < 16; ++i) ot[d][i] *= alpha;
        }
#pragma unroll
        for (int kh = 0; kh < 2; ++kh)
#pragma unroll
            for (int s2 = 0; s2 < 2; ++s2) { u32x4 pa; pa.x = cvtpk(sn[kh][8 * s2], sn[kh][8 * s2 + 1]); pa.y = cvtpk(sn[kh][8 * s2 + 2], sn[kh][8 * s2 + 3]); pa.z = cvtpk(sn[kh][8 * s2 + 4], sn[kh][8 * s2 + 5]); pa.w = cvtpk(sn[kh][8 * s2 + 6], sn[kh][8 * s2 + 7]);
                pp[2 * kh + s2] = pa; }
        { const int n0 = ks1; ks1 = (ks1 + 1) & 3; ks0 = n0; vsm1 = (vsm1 + 1) & 3; vs1 = (vs1 + 1) & 3; }
        asm volatile("s_waitcnt vmcnt(8) lgkmcnt(0)" ::: "memory"); __builtin_amdgcn_s_barrier(); asm volatile("" ::: "memory");
        if (shifted && t1 + 1 < ntile) {
            ps = 0.f;
#pragma unroll
            for (int kh = 0; kh < 2; ++kh)
#pragma unroll
                for (int i = 0; i < 16; ++i) { sc[kh][i] = __builtin_amdgcn_exp2f(sc[kh][i]); ps += sc[kh][i]; }
            l_run += ps;
        }
          }
    }
    { LAS unsigned char* vb = lds + VRING + vsm1 * SLOT + vro;
#pragma unroll
      for (int j = 0; j < 4; ++j) {
          s16x4 lo[4], hi[4];
#pragma unroll
          for (int e = 0; e < 4; ++e) { LAS unsigned char* vp = vb + j * 4096 + ((e ^ q4) * 64);
              lo[e] = __builtin_bit_cast(s16x4, __builtin_amdgcn_ds_read_tr16_b64_v4i16((LAS s16x4*)vp));
              hi[e] = __builtin_bit_cast(s16x4, __builtin_amdgcn_ds_read_tr16_b64_v4i16((LAS s16x4*)(vp + 2048))); }
#pragma unroll
          for (int e = 0; e < 4; ++e) ot[e] = MFMA32(__builtin_shufflevector(lo[e], hi[e], 0, 1, 2, 3, 4, 5, 6, 7), __builtin_bit_cast(bf16x8, pp[j]), ot[e]);
      } }
#undef AT_DMA
#undef AT_ISSUE_K
#undef AT_ISSUE_V
    asm volatile("s_waitcnt vmcnt(0) lgkmcnt(0)" ::: "memory"); __builtin_amdgcn_s_barrier(); asm volatile("" ::: "memory");
    l_run += __shfl_xor(l_run, 32);
    const float inv = 1.f / l_run;
    LAS float* xch = (LAS float*)lds + qg * 4096;
    if (sub == 1) {
#pragma unroll
        for (int d = 0; d < 4; ++d)
#pragma unroll
            for (int i = 0; i < 16; ++i) xch[(d * 16 + i) * 64 + lane] = ot[d][i] * inv * lam;
    }
    __syncthreads();
    if (sub == 0) {
        float ss = 0.f;
#pragma unroll
        for (int d = 0; d < 4; ++d)
#pragma unroll
            for (int i = 0; i < 16; ++i) { const float v = ot[d][i] * inv - xch[(d * 16 + i) * 64 + lane]; ot[d][i] = v; ss += v * v; }
        ss += __shfl_xor(ss, 32);
        const float rs = rsqrtf(ss * (1.f / 128.f) + EPS) * (1.f - lam_init);
        bf16_t* op = O + (qrow0 + 32 * qg + r32) * D + h * 128;
#pragma unroll
        for (int d = 0; d < 4; ++d)
#pragma unroll
            for (int g = 0; g < 4; ++g) { const int dv = 32 * d + 8 * g + 4 * hh; const f32x4 gg = *(const f32x4*)(gsub + dv);
                u32x2 w; w.x = cvtpk(ot[d][4 * g] * rs * gg[0], ot[d][4 * g + 1] * rs * gg[1]); w.y = cvtpk(ot[d][4 * g + 2] * rs * gg[2], ot[d][4 * g + 3] * rs * gg[3]);
                *(u32x2*)(op + dv) = w; }
    }
}
DI void attn_phase(unsigned char* sl, bf16_t* O, int layer, bool ctx_out, const float* lamtab, const float* gsub, LAS unsigned char* lds, bool qsplit) {
    const bf16_t* Q = (const bf16_t*)(sl + 2 * SLAB); const bf16_t* Kp = (const bf16_t*)(sl + 3 * SLAB); const bf16_t* Vp = (const bf16_t*)(sl + 4 * SLAB);
    const float lam = lamtab[layer], lam_init = lamtab[2 + layer];
    const int G = gridDim.x; const int vcu = WG_BLOCKED();
    const int nlat = NB * 8 * 32, ntot = nlat + (ctx_out ? NB * 8 * 2 : 0);
    for (int u = vcu; u < ntot; u += G) {
        if (u < nlat) { const int qb = u & 31, bh = u >> 5, h = bh & 7, b = bh >> 3;
            const size_t q0 = (size_t)b * TP + 128 * qb;
            attn_unit((qsplit && q0 < (size_t)PMQ * 256) ? (const bf16_t*)(sl + 6 * SLAB) : Q, Kp, Vp, O, q0, (size_t)b * TP, TP / 64, h, lam, lam_init, gsub, lds); }
        else { const int v = u - nlat; const int qb = v & 1, bh = v >> 1, h = bh & 7, b = bh >> 3;
            const size_t q0 = (size_t)b * TP + TL + 128 * qb;
            attn_unit((qsplit && q0 < (size_t)PMQ * 256) ? (const bf16_t*)(sl + 6 * SLAB) : Q, Kp, Vp, O, q0, (size_t)b * TP + TL, LC / 64, h, lam, lam_init, gsub, lds); }
    }
}

DI void gmlp_phase(unsigned char* sl, const float* ln_g, const float* ln_b, const float* ws_, const float* bs_, bool skipctx, LAS unsigned char* lds) {
    bf16_t* GU = (bf16_t*)(sl + 3 * SLAB); const bf16_t* GV = (const bf16_t*)(sl + 4 * SLAB);
    const int tid = opaque_tid(), lane = tid & 63, wid = __builtin_amdgcn_readfirstlane(tid >> 6), r32 = lane & 31, hh = lane >> 5;
    LAS float* stat = (LAS float*)(lds + 40960);
    const int nitem = NB * 34 * 8;
    for (int it = blockIdx.x; it < nitem; it += gridDim.x) {
        const int g = it & 7, cidx = it >> 3, b = cidx / 34, cc = cidx % 34;
        if (skipctx && cc >= 32) continue;
        const size_t r0 = (size_t)b * TP + 128 * cc;
        __syncthreads();
        if (tid < 128) { const f32x4* pp_ = (const f32x4*)((const float*)(sl + 5 * SLAB) + (r0 + tid) * 32); float sm = 0.f, sq = 0.f;
#pragma unroll
            for (int i = 0; i < 8; ++i) { const f32x4 v = pp_[i]; sm += v[0] + v[2]; sq += v[1] + v[3]; }
            const float mu = sm * (1.f / 1024.f); const float var = fmaxf(sq * (1.f / 1024.f) - mu * mu, 0.f);
            stat[2 * tid] = mu; stat[2 * tid + 1] = rsqrtf(var + EPS); }
        __syncthreads();
        { const int s = tid >> 2, qd = tid & 3; const bf16_t* rp = GV + (r0 + s) * D + g * 128 + qd * 32; const float mu = stat[2 * s], rs = stat[2 * s + 1];
#pragma unroll
          for (int i = 0; i < 4; ++i) { const u32x4 w = *(const u32x4*)(rp + 8 * i);
              const int cb_ = g * 128 + qd * 32 + 8 * i; const f32x4 lg0 = *(const f32x4*)(ln_g + cb_), lg1 = *(const f32x4*)(ln_g + cb_ + 4), lb0 = *(const f32x4*)(ln_b + cb_), lb1 = *(const f32x4*)(ln_b + cb_ + 4);
#pragma unroll
              for (int e = 0; e < 4; ++e) { const int c = qd * 32 + 8 * i + 2 * e;
                  const float ga = (e < 2) ? lg0[2 * e] : lg1[2 * e - 4], gb = (e < 2) ? lg0[2 * e + 1] : lg1[2 * e - 3], ba = (e < 2) ? lb0[2 * e] : lb1[2 * e - 4], bb = (e < 2) ? lb0[2 * e + 1] : lb1[2 * e - 3];
                  const float v0 = (bflo(w[e]) - mu) * rs * ga + ba, v1 = (bfhi(w[e]) - mu) * rs * gb + bb;
                  *(LAS unsigned short*)(lds + c * 272 + s * 2) = f2bf(v0); *(LAS unsigned short*)(lds + (c + 1) * 272 + s * 2) = f2bf(v1); } } }
        __syncthreads();
        const int tb = wid >> 1, cb0 = 2 * (wid & 1);
        f32x16 acc[2];
#pragma unroll
        for (int t = 0; t < 2; ++t)
#pragma unroll
            for (int i = 0; i < 16; ++i) acc[t][i] = 0.f;
        const float* wrow = ws_ + ((size_t)g * 128 + 32 * tb + r32) * 128 + 8 * hh;
#pragma unroll
        for (int s = 0; s < 8; ++s) { const f32x4 w0 = *(const f32x4*)(wrow + 16 * s), w1 = *(const f32x4*)(wrow + 16 * s + 4);
            u32x4 pa; pa.x = cvtpk(w0[0], w0[1]); pa.y = cvtpk(w0[2], w0[3]); pa.z = cvtpk(w1[0], w1[1]); pa.w = cvtpk(w1[2], w1[3]);
            const bf16x8 af = __builtin_bit_cast(bf16x8, pa);
#pragma unroll
            for (int t = 0; t < 2; ++t) { const bf16x8 bfv = *(const LAS bf16x8*)(lds + (32 * (cb0 + t) + r32) * 272 + (16 * s + 8 * hh) * 2); acc[t] = MFMA32(bfv, af, acc[t]); } }
        { const int tt = 32 * tb + r32; const float bias = bs_[g * 128 + tt];
#pragma unroll
          for (int t = 0; t < 2; ++t)
#pragma unroll
            for (int g4 = 0; g4 < 4; ++g4) { const size_t off = (r0 + tt) * D + g * 128 + 32 * (cb0 + t) + 8 * g4 + 4 * hh;
                const u32x2 gu = *(const u32x2*)(GU + off);
                u32x2 w; w.x = cvtpk(bflo(gu.x) * (acc[t][4 * g4] + bias), bfhi(gu.x) * (acc[t][4 * g4 + 1] + bias)); w.y = cvtpk(bflo(gu.y) * (acc[t][4 * g4 + 2] + bias), bfhi(gu.y) * (acc[t][4 * g4 + 3] + bias));
                *(u32x2*)(GU + off) = w; } }
    }
}

DI void act_phase(const bf16_t* U, bf16_t* ACT, const float* cw, const float* cb, int hf, bool skipctx, int ngt) {
    const int gtid = blockIdx.x * NTHR + opaque_tid();
    constexpr int NCH = DFFH / 8, NSTRIP = M / 16;
    for (int idx = gtid; idx < NSTRIP * NCH; idx += ngt) {
        const int strip = idx / NCH, ch = idx - strip * NCH; const int r0 = strip * 16; const int p0 = r0 % TP;
        if (skipctx && p0 >= TL) continue;
        const int c = ch * 8; const int ca = DFFH * hf + c, cbn = DFF + DFFH * hf + c;
        f32x4 wa[3][2], wb[3][2], ba[2], bb[2];
#pragma unroll
        for (int j = 0; j < 3; ++j) { wa[j][0] = *(const f32x4*)(cw + j * 2 * DFF + ca); wa[j][1] = *(const f32x4*)(cw + j * 2 * DFF + ca + 4); wb[j][0] = *(const f32x4*)(cw + j * 2 * DFF + cbn); wb[j][1] = *(const f32x4*)(cw + j * 2 * DFF + cbn + 4); }
        ba[0] = *(const f32x4*)(cb + ca); ba[1] = *(const f32x4*)(cb + ca + 4); bb[0] = *(const f32x4*)(cb + cbn); bb[1] = *(const f32x4*)(cb + cbn + 4);
        const bf16_t* up = U + (size_t)r0 * DFF + c; bf16_t* op = ACT + (size_t)r0 * DFF + DFFH * hf + c;
        const bool has_prev = (p0 != 0 && p0 != TL), has_next = (p0 + 16 != TL && p0 + 16 != TP);
        const u32x4 z = {0u, 0u, 0u, 0u};
        u32x4 a0 = has_prev ? *(const u32x4*)(up - DFF) : z, b0 = has_prev ? *(const u32x4*)(up - DFF + DFFH) : z;
        u32x4 a1 = *(const u32x4*)up, b1 = *(const u32x4*)(up + DFFH);
#pragma unroll 4
        for (int i = 0; i < 16; ++i) {
            const bool nx = (i < 15) || has_next;
            const u32x4 a2 = nx ? *(const u32x4*)(up + (size_t)(i + 1) * DFF) : z, b2 = nx ? *(const u32x4*)(up + (size_t)(i + 1) * DFF + DFFH) : z;
            u32x4 w;
#pragma unroll
            for (int e = 0; e < 4; ++e) {
                const int v = e >> 1, q0 = (2 * e) & 3, q1 = q0 + 1;
                const float av0 = wa[0][v][q0] * bflo(a0[e]) + wa[1][v][q0] * bflo(a1[e]) + wa[2][v][q0] * bflo(a2[e]) + ba[v][q0];
                const float av1 = wa[0][v][q1] * bfhi(a0[e]) + wa[1][v][q1] * bfhi(a1[e]) + wa[2][v][q1] * bfhi(a2[e]) + ba[v][q1];
                const float bv0 = wb[0][v][q0] * bflo(b0[e]) + wb[1][v][q0] * bflo(b1[e]) + wb[2][v][q0] * bflo(b2[e]) + bb[v][q0];
                const float bv1 = wb[0][v][q1] * bfhi(b0[e]) + wb[1][v][q1] * bfhi(b1[e]) + wb[2][v][q1] * bfhi(b2[e]) + bb[v][q1];
                w[e] = cvtpk(silu_f(av0) * bv0, silu_f(av1) * bv1);
            }
            *(u32x4*)(op + (size_t)i * DFF) = w;
            a0 = a1; a1 = a2; b0 = b1; b1 = b2;
        }
    }
}

#define XB_TMO      128
#define XB_XCNT(j)  (256  + 64 * (j))
#define XB_XSUB(j)  (1280 + 64 * (j))
#define XB_XGEN(j)  (2304 + 64 * (j))
#define XB_TOP      3328
#define XB_TOPGEN   3392
#define XCD_BAR_WORDS 3456
#define XB_SPIN_CAP (1u << 20)
DI unsigned xb_ld(unsigned* p)              { return __hip_atomic_load(p, __ATOMIC_RELAXED, __HIP_MEMORY_SCOPE_AGENT); }
DI unsigned xb_add(unsigned* p, unsigned v) { return __hip_atomic_fetch_add(p, v, __ATOMIC_RELAXED, __HIP_MEMORY_SCOPE_AGENT); }
DI unsigned xb_xcc_id() { return (unsigned)__builtin_amdgcn_s_getreg((3 << 11) | 20) & 0xFu; }
#define XB_SPIN(cond, bar) do { unsigned _sp = 0; while (cond) { __builtin_amdgcn_s_sleep(12); \
    if ((++_sp & 255u) == 0u) { if (xb_ld(&(bar)[XB_TMO])) break; if (_sp > XB_SPIN_CAP) { atomicAdd(&(bar)[XB_TMO], 1u); break; } } } } while (0)
struct XcdBarrier { unsigned* bar; unsigned x; volatile LAS unsigned* st; };
DI XcdBarrier xcd_barrier_post(unsigned* bar, volatile LAS unsigned* st) {
    XcdBarrier b; b.bar = bar; b.x = xb_xcc_id(); b.st = st;
    if (threadIdx.x == 0) { st[2] = xb_add(&bar[XB_XCNT(b.x)], 1u); st[3] = b.x; }
    return b;
}
DI void xcd_barrier_complete(unsigned* bar, unsigned x, unsigned& nloc, unsigned& nx) {
    const unsigned G = gridDim.x * gridDim.y * gridDim.z;
    unsigned sum, cnt, mine, sp = 0u;
    for (;;) {
        sum = 0u; cnt = 0u; mine = 0u;
#pragma unroll
        for (unsigned j = 0; j < 16; ++j) { const unsigned c = xb_ld(&bar[XB_XCNT(j)]); sum += c; cnt += (c > 0u) ? 1u : 0u; mine = (j == x) ? c : mine; }
        if (sum == G) break;
        __builtin_amdgcn_s_sleep(1);
        if ((++sp & 255u) == 0u) { if (xb_ld(&bar[XB_TMO])) break; if (sp > XB_SPIN_CAP) { atomicAdd(&bar[XB_TMO], 1u); break; } }
    }
    nloc = mine > 0u ? mine : 1u; nx = cnt > 0u ? cnt : 1u;
}
DI void xcd_barrier(const XcdBarrier& b) {
    asm volatile("s_waitcnt vmcnt(0)" ::: "memory");
    __syncthreads();
    if (threadIdx.x == 0) {
        unsigned* bar = b.bar;
        __builtin_amdgcn_s_waitcnt(0);
        unsigned nloc = b.st[0], nx = b.st[1];
        if (nloc == 0u) { xcd_barrier_complete(bar, b.x, nloc, nx); b.st[0] = nloc; b.st[1] = nx; }
        const unsigned old = xb_add(&bar[XB_XSUB(b.x)], 1u);
        const unsigned gen = old / nloc;
        if (old + 1u == (gen + 1u) * nloc) {
            __builtin_amdgcn_fence(__ATOMIC_RELEASE, "agent");
            asm volatile("s_waitcnt vmcnt(0)" ::: "memory");
            const unsigned og = xb_add(&bar[XB_TOP], 1u);
            const unsigned tg = og / nx;
            if (og + 1u == (tg + 1u) * nx) xb_add(&bar[XB_TOPGEN], 1u);
            else XB_SPIN(xb_ld(&bar[XB_TOPGEN]) == tg, bar);
            __builtin_amdgcn_fence(__ATOMIC_ACQUIRE, "agent");
            xb_add(&bar[XB_XGEN(b.x)], 1u);
            asm volatile("s_waitcnt vmcnt(0)" ::: "memory");
        } else {
            XB_SPIN(xb_ld(&bar[XB_XGEN(b.x)]) == gen, bar);
            __builtin_amdgcn_fence(__ATOMIC_ACQUIRE, "agent");
            asm volatile("s_waitcnt vmcnt(0)" ::: "memory");
        }
    }
    __syncthreads();
}

DI void xcd_ids(const XcdBarrier& b) {
    if (threadIdx.x == 0) {
        const unsigned rank = b.st[2], x = b.st[3]; unsigned blocked = rank, inter = 0u;
#pragma unroll
        for (unsigned j = 0; j < 16; ++j) { const unsigned c = xb_ld(&b.bar[XB_XCNT(j)]); if (j < x) blocked += c; inter += (c < rank ? c : rank) + ((j < x && c > rank) ? 1u : 0u); }
        b.st[4] = blocked; b.st[5] = inter;
    }
    __syncthreads();
}
#ifndef PROBE_ATT
#define PROBE_ATT 0
#endif
#ifndef PROBE_SCAN
#define PROBE_SCAN 0
#endif
#ifndef PROBE_GEMM
#define PROBE_GEMM 0
#endif
#define GREP for (int rep_ = 0; rep_ < (PROBE_GEMM ? 2 : 1); ++rep_)
#ifndef PROBE_SYNC
#define PROBE_SYNC 0
#endif
#define GSYNC() do { xcd_barrier(xbar); if (PROBE_SYNC) xcd_barrier(xbar); } while (0)
#ifndef PH_MASK
#define PH_MASK 0xFFFFF
#endif
#define PH(b) if ((PH_MASK >> (b)) & 1)
#define WSP (KWS())
#define SLP (KWS() + WS_SL)
#define MODP ((const float*)(KWS() + TAB_MOD))
#define ROPEP ((const float*)(KWS() + TAB_ROPE))
#define LBTP ((const float*)(KWS() + TAB_LB))
#define LAMTP ((const float*)(KWS() + TAB_LAM))
#define XCP ((float*)(KWS() + WS_XC))
#define MODL (MODP + (size_t)l * 9 * 6144)
#define UP_ ((bf16_t*)(SLP + 1 * SLAB))
#define ACTP ((bf16_t*)(SLP + SLAB * 15 / 4))
__global__ void __launch_bounds__(NTHR, 2) fwd_megakernel(Ptrs P) {
    extern __shared__ __attribute__((aligned(16))) unsigned char lds_raw[];
    LAS unsigned char* lds = (LAS unsigned char*)lds_raw;
    cg::grid_group grid = cg::this_grid();
    const int G = gridDim.x, NGW = G * NWAVES, ngt = G * NTHR;
    const size_t TS = (size_t)256 * D * 2;

    unsigned* barw = (unsigned*)(WSP + WS_BAR);
    if (gridDim.x == 0x7fffffffu) grid.sync();
    if (threadIdx.x < 16) ((volatile LAS unsigned*)(lds + LDS_BYTES - 64))[threadIdx.x] = 0u;
    __syncthreads();
    const XcdBarrier xbar = xcd_barrier_post(barw, (volatile LAS unsigned*)(lds + LDS_BYTES - 64));
    PH(0) p0_tables(lds);
    __syncthreads();
    PH(1) convert_weights(0, lds, NGW);
    GSYNC();
    xcd_ids(xbar);
    PH(2) { RW a{}; a.xin_lat = KP(x); a.xin_ctx = KP(ctx); a.Y = nullptr; a.g_pre = KP(g_pre_mix); a.modB = MODP; a.sh_chunk = 0; a.H = (bf16_t*)SLP; a.skipctx = 0; rw_phase(a, NGW); }
    GSYNC();

    for (int l = 0; l < 2; ++l) {
        const bool last = (l == 1); const int skc = last ? 1 : 0;
        const bool hg_split = (G >= 256);
        PH(3) GREP { SchedHG S; S.o.init(136, hg_split ? 16 : 20, G, WG_INTER()); S.A = (const char*)SLP; S.B = (const char*)(WSP + WS_WIN); S.tstep = TS; S.extra = (hg_split && !last) ? 32 : 0; S.qextra = hg_split ? PMQ * 4 : 0;
          EpiIn E{SLP, 0, LBTP + l * 2048, ROPEP}; pg8::gemm_phase(lds, D, S, E); }
        GSYNC();
        if (PROBE_SCAN) { scan_phase(SLP, l, !last, WSP == nullptr, lds); }
        PH(4) scan_phase(SLP, l, !last, true, lds);
        if (hg_split && blockIdx.x >= 128) {
            SchedG S; S.o.init(128, 4, G - 128, (int)blockIdx.x - 128); S.A = (const char*)SLP; S.B = (const char*)(WSP + WS_WIN) + (size_t)4096 * D * 2; S.tstep = TS; S.skipctx = 1;
            EpiIn E{SLP, 3, nullptr, nullptr}; pg8::gemm_phase(lds, D, S, E); }
        GSYNC();
        PH(5) combine_phase(SLP, KP(hg_norm_g) + l * 128, last, NGW);
        GSYNC();
        PH(6) GREP { SchedATQ S; S.o.init(136, 8, G, WG_INTER()); S.A = (const char*)SLP; S.B = (const char*)(WSP + WS_WIN) + (size_t)5120 * D * 2; S.tstep = TS; S.qfirst = hg_split ? PMQ : 0;
          EpiIn E{SLP, 1, nullptr, ROPEP}; pg8::gemm_phase(lds, D, S, E); }
        GSYNC();
        if (PROBE_ATT) { attn_phase(SLP, (bf16_t*)(SLP + 5 * SLAB), l, !last, LAMTP, KP(att_subln_g) + l * 128, lds, hg_split); }
        PH(7) attn_phase(SLP, (bf16_t*)(SLP + 2 * SLAB), l, !last, LAMTP, KP(att_subln_g) + l * 128, lds, hg_split);
        GSYNC();
        PH(8) GREP { SchedG S; S.o.init(last ? 128 : 136, 8, G, WG_INTER()); S.A = (const char*)SLP; S.B = (const char*)(WSP + WS_WIN) + (size_t)8192 * D * 2; S.tstep = TS; S.skipctx = skc;
          EpiIn E{SLP, 2, nullptr, ROPEP}; pg8::gemm_phase(lds, D, S, E); }
        GSYNC();
        PH(9) gmlp_phase(SLP, KP(gm_ln_g) + l * 1024, KP(gm_ln_b) + l * 1024, KP(gm_ws) + (size_t)l * 8 * 128 * 128, KP(gm_bs) + l * 1024, last, lds);
        GSYNC();
        PH(10) GREP { SchedM S; S.o.init(last ? 128 : 136, 4, G, WG_INTER()); S.ws = (const char*)WSP; S.skipctx = skc;
          EpiMerge E{SLP + 5 * SLAB + (size_t)blockIdx.x * (48 * 512 * 16), (bf16_t*)(SLP + 4 * SLAB)}; pg8::gemm_phase(lds, D, S, E); }
        GSYNC();
        PH(11) GREP { SchedG S; S.o.init(last ? 128 : 136, 4, G, WG_INTER()); S.A = (const char*)(SLP + 4 * SLAB); S.B = (const char*)(WSP + WS_WOUT); S.tstep = TS; S.skipctx = skc;
          EpiB16 E{(bf16_t*)(SLP + 2 * SLAB), D}; pg8::gemm_phase(lds, D, S, E); }
        GSYNC();
        PH(12) { RW a{}; a.xin_lat = (l == 0) ? KP(x) : KOUT(); a.xin_ctx = (l == 0) ? KP(ctx) : XCP; a.xo_lat = KOUT(); a.xo_ctx = XCP; a.Y = (const bf16_t*)(SLP + 2 * SLAB); a.g_post = KP(g_post_mix) + l * D; a.modA = MODL; a.gate_chunk = 2;
          a.g_pre = KP(g_pre_ffn) + l * D; a.modB = MODL; a.sh_chunk = 3; a.H = (bf16_t*)SLP; a.skipctx = skc; rw_phase(a, NGW); }
        GSYNC();
        for (int hf = 0; hf < 2; ++hf) {
            PH(13) GREP { SchedG S; S.o.init(last ? 128 : 136, 11, G, WG_INTER()); S.A = (const char*)SLP; S.B = (const char*)(WSP + WS_WUP) + (size_t)hf * DFF * D * 2; S.tstep = TS; S.skipctx = skc;
              EpiB16 E{UP_, DFF}; pg8::gemm_phase(lds, D, S, E); }
            GSYNC();
            PH(14) act_phase(UP_, ACTP, KP(conv_w) + (size_t)l * 3 * 2 * DFF, KP(conv_b) + (size_t)l * 2 * DFF, hf, last, ngt);
            GSYNC();
        }
        PH(15) GREP { SchedG S; S.o.init(last ? 128 : 136, 4, G, WG_INTER()); S.A = (const char*)ACTP; S.B = (const char*)(WSP + WS_WDN); S.tstep = (size_t)256 * DFF * 2; S.skipctx = skc;
          EpiB16 E{(bf16_t*)(SLP + 1 * SLAB), D}; pg8::gemm_phase(lds, DFF, S, E); }
        GSYNC();
        PH(16) { RW a{}; a.xin_lat = KOUT(); a.xin_ctx = XCP; a.xo_lat = KOUT(); a.xo_ctx = XCP; a.Y = (const bf16_t*)(SLP + 1 * SLAB); a.g_post = KP(g_post_ffn) + l * D; a.modA = MODL; a.gate_chunk = 5;
          if (!last) { a.g_pre = KP(g_pre_mix) + (l + 1) * D; a.modB = MODP + (size_t)(l + 1) * 9 * 6144; a.sh_chunk = 0; a.H = (bf16_t*)SLP; }
          a.skipctx = skc; rw_phase(a, NGW); }
        PH(17) if (!last) { convert_weights(l + 1, lds, NGW); GSYNC(); }
    }
}

extern "C" void kernel_launch(void* const* d_in, const int* in_sizes, int n_in, void* d_out, int out_size, void* d_ws, size_t ws_size, hipStream_t stream) {
    static int grid = 0;
    if (grid == 0) {
        if (n_in != 30 || ws_size < WS_END) { fprintf(stderr, "kernel_launch: need 30 inputs and >= %zu bytes of workspace (got %d, %zu)\n", (size_t)WS_END, n_in, ws_size); grid = -1; return; }
        int dev = 0, cus = 0, per_cu = 0;
        hipGetDevice(&dev); hipDeviceGetAttribute(&cus, hipDeviceAttributeMultiprocessorCount, dev);
        hipFuncSetAttribute((const void*)fwd_megakernel, hipFuncAttributeMaxDynamicSharedMemorySize, LDS_BYTES);
        hipOccupancyMaxActiveBlocksPerMultiprocessor(&per_cu, (const void*)fwd_megakernel, NTHR, LDS_BYTES);
        (void)hipGetLastError();
        if (per_cu < 1) per_cu = 1;
        grid = cus * 1;
    }
    if (grid < 0) return;
    Ptrs p{};
    const float** pp = (const float**)&p;
    for (int i = 0; i < 30; ++i) pp[i] = (const float*)d_in[i];
    p.out = (float*)d_out; p.ws = (unsigned char*)d_ws;
    void* args[] = {&p};
    if (hipMemsetAsync((char*)d_ws + WS_BAR, 0, XCD_BAR_WORDS * 4, stream) != hipSuccess) { fprintf(stderr, "kernel_launch: hipMemsetAsync of the barrier words failed\n"); return; }
    hipError_t e = hipLaunchCooperativeKernel((const void*)fwd_megakernel, dim3(grid), dim3(NTHR), args, LDS_BYTES, stream);
    if (e != hipSuccess) fprintf(stderr, "cooperative launch failed: %s (grid %d)\n", hipGetErrorString(e), grid);
}
```

```cpp
#include <hip/hip_runtime.h>
#include <hip/hip_cooperative_groups.h>
#include <cstdio>
#include <cstdint>
namespace cg = cooperative_groups;

#define DI __device__ __forceinline__
#define LAS __attribute__((address_space(3)))
typedef unsigned short bf16_t;
typedef short bf16x8 __attribute__((ext_vector_type(8)));
typedef short s16x4 __attribute__((ext_vector_type(4)));
typedef float f32x4 __attribute__((ext_vector_type(4)));
typedef float f32x16 __attribute__((ext_vector_type(16)));
typedef unsigned u32x4 __attribute__((ext_vector_type(4)));
typedef unsigned u32x2 __attribute__((ext_vector_type(2)));
typedef float f32x2_t __attribute__((ext_vector_type(2)));
typedef __bf16 bf16x2_t __attribute__((ext_vector_type(2)));
DI unsigned cvtpk(float lo, float hi) { f32x2_t v = {lo, hi}; bf16x2_t b = __builtin_convertvector(v, bf16x2_t); return __builtin_bit_cast(unsigned, b); }
DI float bf2f(unsigned short u) { return __uint_as_float(((unsigned)u) << 16); }
DI float bflo(unsigned w) { return __uint_as_float(w << 16); }
DI float bfhi(unsigned w) { return __uint_as_float(w & 0xffff0000u); }
DI unsigned short f2bf(float f) { return (unsigned short)(cvtpk(f, 0.f) & 0xffffu); }
#define MFMA32(a, b, c) __builtin_amdgcn_mfma_f32_32x32x16_bf16((a), (b), (c), 0, 0, 0)
DI int opaque_tid() { int t = threadIdx.x; asm volatile("" : "+v"(t)); return t; }
DI int crow(int reg, int h) { return (reg & 3) + 8 * (reg >> 2) + 4 * h; }

constexpr int D = 1024, NB = 8, TL = 4096, LC = 256, TP = TL + LC, M = NB * TP;
constexpr int DFF = 2816, DFFH = 1408;
constexpr float EPS = 1e-6f;
constexpr float QSCALE = 0.125f * 1.4426950408889634f;
constexpr size_t MiB = (size_t)1 << 20;
constexpr size_t SLAB = (size_t)M * D * 2;
constexpr size_t TAB_MOD = 0;
constexpr size_t TAB_ROPE = 448 * 1024;
constexpr size_t TAB_LB = 460 * 1024;
constexpr size_t TAB_LAM = 480 * 1024;
constexpr size_t WS_BAR = 1024 * 1024;
constexpr size_t WS_WIN = 2 * MiB, WS_WBR = 28 * MiB, WS_WOUT = 34 * MiB, WS_WUP = 36 * MiB, WS_WDN = 47 * MiB;
constexpr size_t WS_XC = 53 * MiB, WS_SL = 62 * MiB, WS_END = WS_SL + SLAB * 13 / 2;
constexpr int NWAVES = 8, NTHR = 512;
constexpr int PMQ = 24;
constexpr int LDS_BYTES = 147456;
#define WG_BLOCKED() ((int)__builtin_amdgcn_readfirstlane((int)((volatile LAS unsigned*)(lds + LDS_BYTES - 64))[4]))
#define WG_INTER()   ((int)__builtin_amdgcn_readfirstlane((int)((volatile LAS unsigned*)(lds + LDS_BYTES - 64))[5]))

namespace pg8 {
constexpr int BM = 256, BK = 64, HALF = 128, HTB = HALF * BK * 2, STAGE_BYTES = 8 * HTB, NXCD = 8, WGM = 8;
DI int lds_byte(int r, int c) { const int st = (r >> 4) * 2 + (c >> 5), rr = r & 15, cc = c & 31, ob = rr * 64 + cc * 2; return st * 1024 + (ob ^ (((ob >> 9) & 1) << 5)); }
DI void stage_rc(int b, int& R, int& C) { const int st = b / 1024, sb = b % 1024, swz = sb ^ (((sb >> 9) & 1) << 5); R = (st >> 1) * 16 + swz / 64; C = (st & 1) * 32 + (swz % 64) / 2; }
DI int perm32(int rho) { const int n = rho >> 4, i = rho & 15; return 8 * (i >> 2) + 4 * n + (i & 3); }
struct Unit { int pm, pn, sub; const char* a; const char* b; };
struct TileOrder {
    int nM, nN, nwg, G, c;
    DI void init(int nM_, int nN_, int G_, int c_) { nM = nM_; nN = nN_; nwg = nM * nN; G = G_; c = c_; }
    DI bool get(long L, int& pm, int& pn) const {
        if (L >= nwg) return false;
        int wgid = (int)L; { const int q = nwg / NXCD, r = nwg % NXCD, xcd = wgid % NXCD, off = wgid / NXCD; wgid = (xcd < r ? xcd * (q + 1) : r * (q + 1) + (xcd - r) * q) + off; }
        const int nig = WGM * nN, gid = wgid / nig, fm = gid * WGM, gsz = (nM - fm) < WGM ? (nM - fm) : WGM;
        pm = fm + ((wgid % nig) % gsz); pn = (wgid % nig) / gsz; return true;
    }
};
template <class Epi, class Sched>
DI void gemm_phase(LAS unsigned char* lds, const int K, const Sched& S, const Epi& E) {
    const int tid = opaque_tid(), wid = __builtin_amdgcn_readfirstlane(tid >> 6), lane = tid & 63, wr = wid >> 2, wc = wid & 3, fr = lane & 15, fq = lane >> 4;
    const int nt = K / BK;
    unsigned voffA[2], voffB[2];
#pragma unroll
    for (int i = 0; i < 2; ++i) { int R, C; stage_rc(tid * 16 + i * 8192, R, C); const int Rb = (R & ~31) + perm32(R & 31);
        voffA[i] = (unsigned)(R * K + C) * 2u; voffB[i] = (unsigned)(Rb * K + C) * 2u; }
    const size_t kstep = (size_t)(BK * 2);
    const size_t hstep = (size_t)HALF * K * 2;
    const unsigned ldsw = (unsigned)wid * 1024u;
    const int aoff = lds_byte(wr * 64 + fr, fq * 8), boff = lds_byte(wc * 32 + fr, fq * 8);
#define PG8_SA(b, h) (((b) * 2 + (h)) * HTB)
#define PG8_SB(b, h) ((4 + (b) * 2 + (h)) * HTB)
#define PG8_STAGE(bufoff, gbase, voff) do { _Pragma("unroll") for (int _i = 0; _i < 2; ++_i) \
        __builtin_amdgcn_global_load_lds((const unsigned*)((const char*)(gbase) + (voff)[_i]), (LAS unsigned*)(lds + (bufoff) + ldsw + _i * 8192), 16, 0, 0); } while (0)
#define PG8_LDA(dst, b, h) do { _Pragma("unroll") for (int m = 0; m < 4; ++m) _Pragma("unroll") for (int k = 0; k < 2; ++k) dst[m][k] = *(const LAS bf16x8*)(lds + PG8_SA(b, h) + aoff + m * 2048 + k * 1024); } while (0)
#define PG8_LDB(dst, b, h) do { _Pragma("unroll") for (int n = 0; n < 2; ++n) _Pragma("unroll") for (int k = 0; k < 2; ++k) dst[n][k] = *(const LAS bf16x8*)(lds + PG8_SB(b, h) + boff + n * 2048 + k * 1024); } while (0)
#define PG8_MMA(ai, bj, At, Bt) do { __builtin_amdgcn_s_setprio(1); _Pragma("unroll") for (int m = 0; m < 4; ++m) _Pragma("unroll") for (int n = 0; n < 2; ++n) _Pragma("unroll") for (int k = 0; k < 2; ++k) \
        acc[ai][bj][m][n] = __builtin_amdgcn_mfma_f32_16x16x32_bf16(Bt[n][k], At[m][k], acc[ai][bj][m][n], 0, 0, 0); __builtin_amdgcn_s_setprio(0); } while (0)
#define PG8_WAIT_V(n) asm volatile("s_waitcnt vmcnt(" #n ")" ::: "memory")
#define PG8_WAIT_L(n) asm volatile("s_waitcnt lgkmcnt(" #n ")" ::: "memory")
#define PG8_BAR __builtin_amdgcn_s_barrier()
#define PG8_SCHED __builtin_amdgcn_sched_barrier(0)
    Unit cur, nxt; int ui = 0;
    if (!S.next(0, cur)) return;
    f32x4 acc[2][2][4][2];
#pragma unroll
    for (int a = 0; a < 2; ++a)
#pragma unroll
        for (int b = 0; b < 2; ++b)
#pragma unroll
            for (int m = 0; m < 4; ++m)
#pragma unroll
                for (int n = 0; n < 2; ++n) acc[a][b][m][n] = (f32x4){0.f, 0.f, 0.f, 0.f};
    bf16x8 At[4][2], B0[2][2], B1[2][2];
    const char* cA = cur.a; const char* cB = cur.b;
    PG8_STAGE(PG8_SB(0, 0), cB, voffB); PG8_STAGE(PG8_SB(0, 1), cB + hstep, voffB); PG8_STAGE(PG8_SA(0, 0), cA, voffA); PG8_STAGE(PG8_SA(0, 1), cA + hstep, voffA);
    if (wr == 1) PG8_BAR;
    PG8_WAIT_V(2); PG8_BAR;
    PG8_STAGE(PG8_SB(1, 0), cB + kstep, voffB); PG8_STAGE(PG8_SA(1, 0), cA + kstep, voffA); PG8_STAGE(PG8_SB(1, 1), cB + hstep + kstep, voffB);
    PG8_WAIT_V(6); PG8_BAR;
    for (;;) {
        const bool has_next = S.next(ui + 1, nxt);
        const char* nA = has_next ? nxt.a : cA; const char* nB = has_next ? nxt.b : cB;
        for (int t = 0; t < nt; t += 2) {
            const bool last = (t == nt - 2);
            const char* a1 = cA + (size_t)(t + 1) * kstep;
            const char* a2 = last ? nA : cA + (size_t)(t + 2) * kstep; const char* b2 = last ? nB : cB + (size_t)(t + 2) * kstep;
            const char* a3 = a2 + kstep; const char* b3 = b2 + kstep;
            PG8_LDB(B0, 0, 0); PG8_LDB(B1, 0, 1); PG8_SCHED; PG8_LDA(At, 0, 0); PG8_STAGE(PG8_SA(1, 1), a1 + hstep, voffA);
            PG8_WAIT_V(8); PG8_WAIT_L(0); PG8_BAR; PG8_MMA(0, 0, At, B0); PG8_MMA(0, 1, At, B1); PG8_BAR; PG8_SCHED;
            PG8_LDA(At, 0, 1); PG8_STAGE(PG8_SB(0, 0), b2, voffB); PG8_STAGE(PG8_SB(0, 1), b2 + hstep, voffB); PG8_STAGE(PG8_SA(0, 0), a2, voffA);
            PG8_WAIT_V(8); PG8_WAIT_L(0); PG8_BAR; PG8_MMA(1, 0, At, B0); PG8_MMA(1, 1, At, B1); PG8_BAR; PG8_SCHED;
            PG8_LDB(B0, 1, 0); PG8_LDB(B1, 1, 1); PG8_SCHED; PG8_LDA(At, 1, 0); PG8_STAGE(PG8_SA(0, 1), a2 + hstep, voffA);
            PG8_WAIT_V(8); PG8_WAIT_L(0); PG8_BAR; PG8_MMA(0, 0, At, B0); PG8_MMA(0, 1, At, B1); PG8_BAR; PG8_SCHED;
            PG8_LDA(At, 1, 1); PG8_STAGE(PG8_SB(1, 0), b3, voffB); PG8_STAGE(PG8_SB(1, 1), b3 + hstep, voffB); PG8_STAGE(PG8_SA(1, 0), a3, voffA);
            PG8_WAIT_V(8); PG8_WAIT_L(0); PG8_BAR; PG8_MMA(1, 0, At, B0); PG8_MMA(1, 1, At, B1); PG8_BAR; PG8_SCHED;
        }
        if (wr == 0) PG8_BAR;
        { int efr = fr, efq = fq; asm volatile("" : "+v"(efr), "+v"(efq)); E(acc, cur, wr, wc, efr, efq); }
        if (!has_next) break;
#pragma unroll
        for (int a = 0; a < 2; ++a)
#pragma unroll
            for (int b = 0; b < 2; ++b)
#pragma unroll
                for (int m = 0; m < 4; ++m)
#pragma unroll
                    for (int n = 0; n < 2; ++n) acc[a][b][m][n] = (f32x4){0.f, 0.f, 0.f, 0.f};
        cur = nxt; cA = nA; cB = nB; ++ui;
        if (wr == 1) PG8_BAR;
    }
    PG8_WAIT_V(0);
    PG8_BAR;
#undef PG8_SA
#undef PG8_SB
#undef PG8_STAGE
#undef PG8_LDA
#undef PG8_LDB
#undef PG8_MMA
#undef PG8_WAIT_V
#undef PG8_WAIT_L
#undef PG8_BAR
#undef PG8_SCHED
}
}
typedef f32x4 AccT[2][2][4][2];

struct SchedG {
    pg8::TileOrder o; const char* A; const char* B; size_t tstep; int skipctx;
    DI bool next(int i, pg8::Unit& u) const {
        int pm, pn; if (!o.get((long)i * o.G + o.c, pm, pn)) return false;
        if (skipctx) pm += pm >> 4;
        u.pm = pm; u.pn = pn; u.sub = 0; u.a = A + (size_t)pm * tstep; u.b = B + (size_t)pn * tstep; return true;
    }
};
struct SchedHG {
    pg8::TileOrder o; const char* A; const char* B; size_t tstep; int extra, qextra;
    DI bool next(int i, pg8::Unit& u) const {
        const long L = (long)i * o.G + o.c; int pm, pn, pb;
        if (L < o.nwg) { o.get(L, pm, pn); pb = pn; }
        else if (L < o.nwg + extra) { const int j = (int)(L - o.nwg); pm = 17 * (j >> 2) + 16; pn = 16 + (j & 3); pb = pn; }
        else if (L < o.nwg + extra + qextra) { const int j = (int)(L - o.nwg - extra); pm = j >> 2; pn = 100 + (j & 3); pb = 20 + (j & 3); }
        else return false;
        u.pm = pm; u.pn = pn; u.sub = 0; u.a = A + (size_t)pm * tstep; u.b = B + (size_t)pb * tstep; return true;
    }
};
struct SchedATQ {
    pg8::TileOrder o; const char* A; const char* B; size_t tstep; int qfirst;
    DI bool next(int i, pg8::Unit& u) const {
        const long L = (long)i * o.G + o.c; int pm, pn;
        if (L < o.nwg) { o.get(L, pm, pn); pn += 4; }
        else { const int j = (int)(L - o.nwg); pm = qfirst + (j >> 2); pn = j & 3; if (pm >= 136) return false; }
        u.pm = pm; u.pn = pn; u.sub = 0; u.a = A + (size_t)pm * tstep; u.b = B + (size_t)pn * tstep; return true;
    }
};
struct SchedM {
    pg8::TileOrder o; const char* ws; int skipctx;
    DI bool next(int i, pg8::Unit& u) const {
        const int ti = i / 6, sub = i - ti * 6;
        int pm, pn; if (!o.get((long)ti * o.G + o.c, pm, pn)) return false;
        if (skipctx) pm += pm >> 4;
        const int j = sub >> 1; const size_t tstep = (size_t)256 * D * 2;
        u.pm = pm; u.pn = pn; u.sub = sub;
        if (sub & 1) { const size_t yo = (j == 0) ? 2 * SLAB : (j == 1 ? 3 * SLAB : 1 * SLAB); u.a = ws + WS_SL + yo + (size_t)pm * tstep; u.b = ws + WS_WBR + (size_t)j * (2 * MiB) + (size_t)pn * tstep; }
        else { u.a = ws + WS_SL + (size_t)pm * tstep; u.b = ws + WS_WIN + (size_t)10240 * D * 2 + (size_t)j * (2 * MiB) + (size_t)pn * tstep; }
        return true;
    }
};

DI float silu_f(float v) { return v * __builtin_amdgcn_rcpf(1.f + __builtin_amdgcn_exp2f(-1.4426950408889634f * v)); }
DI float gelu_f(float v) { const float z = (-1.5957691216f * 1.4426950408889634f) * (v + 0.044715f * v * v * v); return v * __builtin_amdgcn_rcpf(1.f + __builtin_amdgcn_exp2f(z)); }
DI float sigm_f(float v) { return __builtin_amdgcn_rcpf(1.f + __builtin_amdgcn_exp2f(-1.4426950408889634f * v)); }
DI float logf_gate(float z, float lbv) {
    const float sg = __builtin_amdgcn_rcpf(1.f + __builtin_amdgcn_exp2f(-1.4426950408889634f * z));
    const float f = fmaxf(lbv + (1.f - lbv) * sg, 1e-30f);
    return 0.6931471805599453f * __builtin_amdgcn_logf(f);
}
template <int TYPE>
DI void epi_apply(const AccT& acc, const pg8::Unit& u, int ct, int wr, int wc, int fr, int fq, bf16_t* dst, const float* lbp, const float* rope, float* rstat = nullptr) {
    const int row0 = u.pm * 256 + wr * 64 + fr; const int c0 = ct * 256 + wc * 32 + 8 * fq;
    const bool isctx = ((u.pm % 17) == 16);
    f32x4 lbq[2][2];
    if (TYPE == 3) {
#pragma unroll
        for (int bj = 0; bj < 2; ++bj) { lbq[bj][0] = *(const f32x4*)(lbp + c0 + bj * 128); lbq[bj][1] = *(const f32x4*)(lbp + c0 + bj * 128 + 4); }
    }
#pragma unroll
    for (int ai = 0; ai < 2; ++ai) {
      f32x4 csq[4], snq[4];
      if (TYPE == 4 || TYPE == 5) {
#pragma unroll
          for (int q = 0; q < 4; ++q) { csq[q] = (f32x4){1.f, 1.f, 1.f, 1.f}; snq[q] = (f32x4){0.f, 0.f, 0.f, 0.f}; }
          if (!isctx) {
#pragma unroll
              for (int q = 0; q < 4; ++q) { const int row = row0 + ai * 128 + q * 16; const int p = row - (u.pm / 17) * TP; const int pos = (wc & 1) ? (p & 63) : (p >> 6);
                  csq[q] = *(const f32x4*)(rope + pos * 16 + 4 * fq); snq[q] = *(const f32x4*)(rope + 1024 + pos * 16 + 4 * fq); }
          }
      }
#pragma unroll
        for (int m = 0; m < 4; ++m) {
            const int row = row0 + ai * 128 + m * 16;
            bf16_t* rowp = dst + (size_t)row * D + c0;
            float rs_ = 0.f, rq_ = 0.f;
            f32x4 cs = {1.f, 1.f, 1.f, 1.f}, sn = {0.f, 0.f, 0.f, 0.f};
            if (TYPE == 4 || TYPE == 5) { cs = csq[m]; sn = snq[m]; }
#pragma unroll
            for (int bj = 0; bj < 2; ++bj) {
                f32x4 v0 = acc[ai][bj][m][0], v1 = acc[ai][bj][m][1];
                if (TYPE == 1) {
#pragma unroll
                    for (int i = 0; i < 4; ++i) { v0[i] = silu_f(v0[i]); v1[i] = silu_f(v1[i]); }
                } else if (TYPE == 2 || TYPE == 6) {
#pragma unroll
                    for (int i = 0; i < 4; ++i) { v0[i] = gelu_f(v0[i]); v1[i] = gelu_f(v1[i]); }
                    if (TYPE == 6) {
#pragma unroll
                        for (int i = 0; i < 4; ++i) { rs_ += v0[i] + v1[i]; rq_ += v0[i] * v0[i] + v1[i] * v1[i]; }
                    }
                } else if (TYPE == 3) {
                    const f32x4 lb0 = lbq[bj][0], lb1 = lbq[bj][1];
#pragma unroll
                    for (int i = 0; i < 4; ++i) { v0[i] = logf_gate(v0[i], lb0[i]); v1[i] = logf_gate(v1[i], lb1[i]); }
                } else if (TYPE == 4 || TYPE == 5) {
                    const f32x4 o0 = v0 * cs - v1 * sn, o1 = v1 * cs + v0 * sn;
                    v0 = o0; v1 = o1;
                    if (TYPE == 4) { v0 = v0 * QSCALE; v1 = v1 * QSCALE; }
                }
                u32x4 w; w.x = cvtpk(v0[0], v0[1]); w.y = cvtpk(v0[2], v0[3]); w.z = cvtpk(v1[0], v1[1]); w.w = cvtpk(v1[2], v1[3]);
                *(u32x4*)(rowp + bj * 128) = w;
                __builtin_amdgcn_sched_barrier(0);
            }
            if (TYPE == 6) {
                rs_ += __shfl_xor(rs_, 16); rs_ += __shfl_xor(rs_, 32); rq_ += __shfl_xor(rq_, 16); rq_ += __shfl_xor(rq_, 32);
                if (fq == 0) { f32x2_t* sp_ = (f32x2_t*)(rstat + ((size_t)row * 16 + ct * 4 + wc) * 2); *sp_ = (f32x2_t){rs_, rq_}; }
            }
        }
    }
}
struct EpiIn {
    unsigned char* sl; int stage; const float* lb; const float* rope;
    DI void operator()(const AccT& acc, const pg8::Unit& u, int wr, int wc, int fr, int fq) const {
        const int blk = u.pn >> 2, ct = u.pn & 3;
        if (stage == 3) { epi_apply<1>(acc, u, ct, wr, wc, fr, fq, (bf16_t*)(sl + 5 * SLAB), nullptr, nullptr); return; }
        if (stage == 0) {
            if (u.pn >= 100) { epi_apply<4>(acc, u, u.pn - 100, wr, wc, fr, fq, (bf16_t*)(sl + 6 * SLAB), nullptr, rope); return; }
            if (blk == 0) epi_apply<1>(acc, u, ct, wr, wc, fr, fq, (bf16_t*)(sl + 1 * SLAB), nullptr, nullptr);
            else if (blk == 1) epi_apply<3>(acc, u, ct, wr, wc, fr, fq, (bf16_t*)(sl + 2 * SLAB), lb, nullptr);
            else if (blk == 2) epi_apply<3>(acc, u, ct, wr, wc, fr, fq, (bf16_t*)(sl + 3 * SLAB), lb + 1024, nullptr);
            else if (blk == 3) epi_apply<0>(acc, u, ct, wr, wc, fr, fq, (bf16_t*)(sl + 4 * SLAB), nullptr, nullptr);
            else epi_apply<1>(acc, u, ct, wr, wc, fr, fq, (bf16_t*)(sl + 5 * SLAB), nullptr, nullptr);
        } else if (stage == 1) {
            if (blk == 0) epi_apply<4>(acc, u, ct, wr, wc, fr, fq, (bf16_t*)(sl + 2 * SLAB), nullptr, rope);
            else if (blk == 1) epi_apply<5>(acc, u, ct, wr, wc, fr, fq, (bf16_t*)(sl + 3 * SLAB), nullptr, rope);
            else epi_apply<0>(acc, u, ct, wr, wc, fr, fq, (bf16_t*)(sl + 4 * SLAB), nullptr, nullptr);
        } else {
            if (blk == 0) epi_apply<2>(acc, u, ct, wr, wc, fr, fq, (bf16_t*)(sl + 3 * SLAB), nullptr, nullptr);
            else epi_apply<6>(acc, u, ct, wr, wc, fr, fq, (bf16_t*)(sl + 4 * SLAB), nullptr, nullptr, (float*)(sl + 5 * SLAB));
        }
    }
};
struct EpiF32 {
    float* Y; int ldc;
    DI void operator()(const AccT& acc, const pg8::Unit& u, int wr, int wc, int fr, int fq) const {
        const int row0 = u.pm * 256 + wr * 64 + fr; const int c0 = u.pn * 256 + wc * 32 + 8 * fq;
#pragma unroll
        for (int ai = 0; ai < 2; ++ai)
#pragma unroll
            for (int m = 0; m < 4; ++m) { float* rowp = Y + (size_t)(row0 + ai * 128 + m * 16) * ldc + c0;
#pragma unroll
                for (int bj = 0; bj < 2; ++bj) { *(f32x4*)(rowp + bj * 128) = acc[ai][bj][m][0]; *(f32x4*)(rowp + bj * 128 + 4) = acc[ai][bj][m][1]; } }
    }
};
struct EpiB16 {
    bf16_t* O; int ldc;
    DI void operator()(const AccT& acc, const pg8::Unit& u, int wr, int wc, int fr, int fq) const {
        const int row0 = u.pm * 256 + wr * 64 + fr; const int c0 = u.pn * 256 + wc * 32 + 8 * fq;
#pragma unroll
        for (int ai = 0; ai < 2; ++ai)
#pragma unroll
            for (int m = 0; m < 4; ++m) { bf16_t* rowp = O + (size_t)(row0 + ai * 128 + m * 16) * ldc + c0;
#pragma unroll
                for (int bj = 0; bj < 2; ++bj) { const f32x4 v0 = acc[ai][bj][m][0], v1 = acc[ai][bj][m][1];
                    u32x4 w; w.x = cvtpk(v0[0], v0[1]); w.y = cvtpk(v0[2], v0[3]); w.z = cvtpk(v1[0], v1[1]); w.w = cvtpk(v1[2], v1[3]);
                    *(u32x4*)(rowp + bj * 128) = w; } }
    }
};
struct EpiMerge {
    unsigned char* scr;
    bf16_t* Ys;
    DI void operator()(const AccT& acc, const pg8::Unit& u, int wr, int wc, int fr, int fq) const {
        const int tid = opaque_tid();
        unsigned char* gsc = scr; unsigned char* ysc = scr + 16 * 512 * 16; unsigned to = (unsigned)tid * 16u; asm volatile("" : "+v"(to));
        const int sub = u.sub;
        if ((sub & 1) == 0) {
#pragma unroll
            for (int ai = 0; ai < 2; ++ai)
#pragma unroll
                for (int bj = 0; bj < 2; ++bj)
#pragma unroll
                    for (int m = 0; m < 4; ++m) { const f32x4 v0 = acc[ai][bj][m][0], v1 = acc[ai][bj][m][1];
                        u32x4 w; w.x = cvtpk(sigm_f(v0[0]), sigm_f(v0[1])); w.y = cvtpk(sigm_f(v0[2]), sigm_f(v0[3])); w.z = cvtpk(sigm_f(v1[0]), sigm_f(v1[1])); w.w = cvtpk(sigm_f(v1[2]), sigm_f(v1[3]));
                        *(u32x4*)(gsc + ((ai * 2 + bj) * 4 + m) * 8192 + to) = w; __builtin_amdgcn_sched_barrier(0); }
        } else {
            const int row0 = u.pm * 256 + wr * 64 + fr; const int c0 = u.pn * 256 + wc * 32 + 8 * fq;
#pragma unroll
            for (int ai = 0; ai < 2; ++ai)
#pragma unroll
                for (int bj = 0; bj < 2; ++bj) {
                    u32x4 g[4], ys[4];
#pragma unroll
                    for (int m = 0; m < 4; ++m) { const int e = (ai * 2 + bj) * 4 + m; g[m] = *(const u32x4*)(gsc + e * 8192 + to);
                        ys[m] = (sub > 1) ? *(const u32x4*)(ysc + e * 8192 + to) : (u32x4){0u, 0u, 0u, 0u}; }
#pragma unroll
                    for (int m = 0; m < 4; ++m) { const int e = (ai * 2 + bj) * 4 + m;
                        f32x4 y0 = acc[ai][bj][m][0], y1 = acc[ai][bj][m][1];
                        y0[0] = y0[0] * bflo(g[m].x) + bflo(ys[m].x); y0[1] = y0[1] * bfhi(g[m].x) + bfhi(ys[m].x); y0[2] = y0[2] * bflo(g[m].y) + bflo(ys[m].y); y0[3] = y0[3] * bfhi(g[m].y) + bfhi(ys[m].y);
                        y1[0] = y1[0] * bflo(g[m].z) + bflo(ys[m].z); y1[1] = y1[1] * bfhi(g[m].z) + bfhi(ys[m].z); y1[2] = y1[2] * bflo(g[m].w) + bflo(ys[m].w); y1[3] = y1[3] * bfhi(g[m].w) + bfhi(ys[m].w);
                        u32x4 w; w.x = cvtpk(y0[0], y0[1]); w.y = cvtpk(y0[2], y0[3]); w.z = cvtpk(y1[0], y1[1]); w.w = cvtpk(y1[2], y1[3]);
                        if (sub < 5) *(u32x4*)(ysc + e * 8192 + to) = w;
                        else *(u32x4*)(Ys + (size_t)(row0 + ai * 128 + m * 16) * D + c0 + bj * 128) = w; }
                    __builtin_amdgcn_sched_barrier(0);
                }
        }
    }
};

DI float wave_sum(float v) {
#pragma unroll
    for (int o = 1; o < 64; o <<= 1) v += __shfl_xor(v, o);
    return v;
}
struct Ptrs {
    const float *x, *c, *ctx, *c_ctx, *w_ada, *b_ada, *g_pre_mix, *g_post_mix, *g_pre_ffn, *g_post_ffn, *w_in, *lam_q1, *lam_k1, *lam_q2, *lam_k2,
        *att_subln_g, *gm_ln_g, *gm_ln_b, *gm_ws, *gm_bs, *hg_lb, *hg_norm_g, *w_br_att, *w_br_gm, *w_br_hg, *w_out, *w_up, *conv_w, *conv_b, *w_down;
    float* out; unsigned char* ws;
};

DI const void* karg_load(int off) {
    const volatile __attribute__((address_space(4))) unsigned long long* p = (const volatile __attribute__((address_space(4))) unsigned long long*)((const __attribute__((address_space(4))) char*)__builtin_amdgcn_kernarg_segment_ptr() + off);
    return (const void*)(*p);
}
#define KP(name) ((const float*)karg_load((int)__builtin_offsetof(Ptrs, name)))
#define KWS() ((unsigned char*)karg_load((int)__builtin_offsetof(Ptrs, ws)))
#define KOUT() ((float*)karg_load((int)__builtin_offsetof(Ptrs, out)))

DI void transpose_item(const float* W, int K, int Nsrc, int src0, bf16_t* WT, int dst0, int k0, bool perm, LAS float* scr, int lane) {
    { float wv[32];
#pragma unroll
      for (int i = 0; i < 32; ++i) wv[i] = W[(size_t)(k0 + 2 * i + (lane >> 5)) * Nsrc + src0 + (lane & 31)];
#pragma unroll
      for (int i = 0; i < 32; ++i) scr[(2 * i + (lane >> 5)) * 33 + (lane & 31)] = wv[i]; }
    asm volatile("s_waitcnt lgkmcnt(0)" ::: "memory");
    const int c = lane & 7;
#pragma unroll
    for (int j = 0; j < 4; ++j) { const int n = (lane >> 3) + 8 * j;
        int ns = n; if (perm) { const int f = n >> 3, i = n & 7; ns = 4 * f + (i & 3) + 16 * (i >> 2); }
        const LAS float* s = scr + (8 * c) * 33 + ns;
        u32x4 o; o.x = cvtpk(s[0 * 33], s[1 * 33]); o.y = cvtpk(s[2 * 33], s[3 * 33]); o.z = cvtpk(s[4 * 33], s[5 * 33]); o.w = cvtpk(s[6 * 33], s[7 * 33]);
        *(u32x4*)(WT + (size_t)(dst0 + n) * K + k0 + 8 * c) = o; }
    asm volatile("s_waitcnt lgkmcnt(0)" ::: "memory");
}
DI void convert_weights(int l, LAS unsigned char* lds, int NGW) {
    const int tid = opaque_tid(), lane = tid & 63, wave = __builtin_amdgcn_readfirstlane(tid >> 6); const int gw = blockIdx.x * NWAVES + wave;
    LAS float* scr = (LAS float*)(lds + wave * 16384);
    unsigned char* ws = KWS();
    constexpr int I_IN = 416 * 16, I_BR = 32 * 16, I_UP = 176 * 16, I_DN = 32 * 44;
    constexpr int NIT = I_IN + 4 * I_BR + I_UP + I_DN;
    for (int it = gw; it < NIT; it += NGW) {
        int r = it;
        if (r < I_IN) { const int kb = r / 416, nb = r % 416; const int db = nb >> 5;
            const int sb = (db < 5) ? (5 + db) : (db < 10 ? (db - 5) : db);
            transpose_item(KP(w_in) + (size_t)l * D * 13312, D, 13312, sb * 1024 + (nb & 31) * 32, (bf16_t*)(ws + WS_WIN), nb * 32, kb * 64, (db == 5 || db == 6), scr, lane); continue; }
        r -= I_IN;
        if (r < 4 * I_BR) { const int j = r / I_BR, rr = r % I_BR; const int kb = rr / 32, nb = rr % 32;
            const float* W = (j == 0 ? KP(w_br_att) : j == 1 ? KP(w_br_gm) : j == 2 ? KP(w_br_hg) : KP(w_out)) + (size_t)l * D * D;
            bf16_t* dst = (bf16_t*)(ws + (j < 3 ? WS_WBR + (size_t)j * 2 * MiB : WS_WOUT));
            transpose_item(W, D, D, nb * 32, dst, nb * 32, kb * 64, false, scr, lane); continue; }
        r -= 4 * I_BR;
        if (r < I_UP) { const int kb = r / 176, nb = r % 176; const int j0 = nb * 32; const int hf = j0 / DFF, jj = j0 % DFF;
            const int src = (jj < DFFH) ? (DFFH * hf + jj) : (DFF + DFFH * hf + (jj - DFFH));
            transpose_item(KP(w_up) + (size_t)l * D * 2 * DFF, D, 2 * DFF, src, (bf16_t*)(ws + WS_WUP), j0, kb * 64, false, scr, lane); continue; }
        r -= I_UP;
        { const int kb = r / 32, nb = r % 32;
          transpose_item(KP(w_down) + (size_t)l * DFF * D, DFF, D, nb * 32, (bf16_t*)(ws + WS_WDN), nb * 32, kb * 64, false, scr, lane); }
    }
}

struct RW {
    const float* xin_lat; const float* xin_ctx; float* xo_lat; float* xo_ctx;
    const bf16_t* Y; const float* g_post; const float* modA; int gate_chunk;
    const float* g_pre; const float* modB; int sh_chunk; bf16_t* H; int skipctx;
};
DI void rw_phase(const RW& a, int NGW) {
    const int tid = opaque_tid(), lane = tid & 63; const int gw = blockIdx.x * NWAVES + __builtin_amdgcn_readfirstlane(tid >> 6);
    int r = gw;
    if (a.skipctx) { while (r < M && (r % TP) >= TL) r += NGW; }
    f32x4 xn[4], yn[4];
#define RW_LOAD(rr) do { const int b_ = (rr) / TP, p_ = (rr) - b_ * TP; const bool c_ = p_ >= TL; const size_t xo_ = c_ ? (size_t)(b_ * LC + p_ - TL) * D : (size_t)(b_ * TL + p_) * D; \
        const float* xi_ = (c_ ? a.xin_ctx : a.xin_lat) + xo_; _Pragma("unroll") for (int j = 0; j < 4; ++j) xn[j] = *(const f32x4*)(xi_ + 4 * lane + 256 * j); \
        if (a.Y) { const bf16_t* yr_ = a.Y + (size_t)(rr) * D; _Pragma("unroll") for (int j = 0; j < 4; ++j) { const u32x2 w_ = *(const u32x2*)(yr_ + 4 * lane + 256 * j); yn[j] = (f32x4){bflo(w_.x), bfhi(w_.x), bflo(w_.y), bfhi(w_.y)}; } } } while (0)
    if (r < M) RW_LOAD(r);
    f32x4 gpo[4], gpr[4];
#pragma unroll
    for (int j = 0; j < 4; ++j) { gpo[j] = a.Y ? *(const f32x4*)(a.g_post + 4 * lane + 256 * j) : (f32x4){0.f, 0.f, 0.f, 0.f}; gpr[j] = a.H ? *(const f32x4*)(a.g_pre + 4 * lane + 256 * j) : (f32x4){0.f, 0.f, 0.f, 0.f}; }
    while (r < M) {
        const int b = r / TP, p = r - b * TP; const bool isctx = p >= TL;
        const size_t xoff = isctx ? (size_t)(b * LC + p - TL) * D : (size_t)(b * TL + p) * D;
        const int mr = isctx ? 8 : b;
        f32x4 x[4], y[4];
#pragma unroll
        for (int j = 0; j < 4; ++j) { x[j] = xn[j]; y[j] = yn[j]; }
        int rn = r + NGW;
        if (a.skipctx) { while (rn < M && (rn % TP) >= TL) rn += NGW; }
        if (rn < M) RW_LOAD(rn);
        f32x4 gq[4], s1q[4], s2q[4];
        if (a.Y) { const float* gt = a.modA + (size_t)mr * 6144 + a.gate_chunk * 1024;
#pragma unroll
            for (int j = 0; j < 4; ++j) gq[j] = *(const f32x4*)(gt + 4 * lane + 256 * j); }
        if (a.H) { const float* sh = a.modB + (size_t)mr * 6144 + a.sh_chunk * 1024;
#pragma unroll
            for (int j = 0; j < 4; ++j) { s1q[j] = *(const f32x4*)(sh + 4 * lane + 256 * j); s2q[j] = *(const f32x4*)(sh + 1024 + 4 * lane + 256 * j); } }
        if (a.Y) {
            float ss = 0.f;
#pragma unroll
            for (int j = 0; j < 4; ++j) ss += (y[j][0] * y[j][0] + y[j][1] * y[j][1]) + (y[j][2] * y[j][2] + y[j][3] * y[j][3]);
            const float rs = rsqrtf(wave_sum(ss) * (1.f / D) + EPS);
            float* xo = (isctx ? a.xo_ctx : a.xo_lat) + xoff;
#pragma unroll
            for (int j = 0; j < 4; ++j) { x[j] = x[j] + gq[j] * (y[j] * rs * gpo[j]); *(f32x4*)(xo + 4 * lane + 256 * j) = x[j]; }
        }
        if (a.H) {
            float ss = 0.f;
#pragma unroll
            for (int j = 0; j < 4; ++j) ss += (x[j][0] * x[j][0] + x[j][1] * x[j][1]) + (x[j][2] * x[j][2] + x[j][3] * x[j][3]);
            const float rs = rsqrtf(wave_sum(ss) * (1.f / D) + EPS);
            bf16_t* hr = a.H + (size_t)r * D;
#pragma unroll
            for (int j = 0; j < 4; ++j) { const f32x4 h = (x[j] * rs * gpr[j]) * (s2q[j] + 1.f) + s1q[j];
                u32x2 w; w.x = cvtpk(h[0], h[1]); w.y = cvtpk(h[2], h[3]); *(u32x2*)(hr + 4 * lane + 256 * j) = w; }
        }
        r = rn;
    }
#undef RW_LOAD
}

DI void p0_tables(LAS unsigned char* lds) {
    const int tid = opaque_tid();
    unsigned char* ws0 = KWS(); float* mod = (float*)(ws0 + TAB_MOD);
    const float* pc = KP(c); const float* pcc = KP(c_ctx); const float* pwa = KP(w_ada); const float* pba = KP(b_ada);
    LAS float* sc = (LAS float*)lds;
    LAS float* part = (LAS float*)(lds + 40960);
    for (int it = blockIdx.x; it < 192; it += gridDim.x) {
        const int l = it / 96, n0 = (it % 96) * 64;
        __syncthreads();
        for (int i = tid; i < 9 * 1024; i += NTHR) { const int r = i >> 10, k = i & 1023; const float v = (r < 8) ? pc[r * 1024 + k] : pcc[k]; sc[i] = v / (1.f + __expf(-v)); }
        __syncthreads();
        const int col = tid & 63, ks = tid >> 6;
        float a[9];
#pragma unroll
        for (int r = 0; r < 9; ++r) a[r] = 0.f;
        const float* w = pwa + (size_t)l * D * 6144 + n0 + col;
        for (int k0 = ks * 128; k0 < ks * 128 + 128; k0 += 16) { float wv[16];
#pragma unroll
            for (int j = 0; j < 16; ++j) wv[j] = w[(size_t)(k0 + j) * 6144];
#pragma unroll
            for (int j = 0; j < 16; ++j)
#pragma unroll
                for (int r = 0; r < 9; ++r) a[r] += sc[r * 1024 + k0 + j] * wv[j]; }
#pragma unroll
        for (int r = 0; r < 9; ++r) part[(ks * 9 + r) * 64 + col] = a[r];
        __syncthreads();
        for (int i = tid; i < 576; i += NTHR) { const int r = i >> 6, cc = i & 63; float s = 0.f;
#pragma unroll
            for (int q = 0; q < 8; ++q) s += part[(q * 9 + r) * 64 + cc];
            mod[((size_t)l * 9 + r) * 6144 + n0 + cc] = s + pba[l * 6144 + n0 + cc]; }
    }
    if (blockIdx.x == gridDim.x - 1) {
        float* rope = (float*)(ws0 + TAB_ROPE); float* lb = (float*)(ws0 + TAB_LB); float* lam = (float*)(ws0 + TAB_LAM);
        const float* phl = KP(hg_lb); const float* q1 = KP(lam_q1); const float* k1 = KP(lam_k1); const float* q2 = KP(lam_q2); const float* k2 = KP(lam_k2);
        for (int i = tid; i < 1024; i += NTHR) { const int pos = i >> 4, f = i & 15; const float inv = exp2f(-(float)f * (13.287712379549449f / 16.f)); const float ang = (float)pos * inv;
            rope[i] = cosf(ang); rope[1024 + i] = sinf(ang); }
        for (int i = tid; i < 2048; i += NTHR) { lb[i] = 0.f; const float l0 = phl[i], l1 = phl[2048 + i]; lb[2048 + i] = 1.f / (1.f + expf(l0 - l1)); }
        if (tid < 2) { const int l = tid; float s1 = 0.f, s2 = 0.f; for (int i = 0; i < 64; ++i) { s1 += q1[l * 64 + i] * k1[l * 64 + i]; s2 += q2[l * 64 + i] * k2[l * 64 + i]; }
            const float li = 0.8f - 0.6f * expf(-0.3f * (float)l); lam[l] = expf(s1) - expf(s2) + li; lam[2 + l] = li; }
    }
}

constexpr int SC_QH = 0, SC_KH = 17408, SC_KT = 34816, SC_VT = 53248, SC_ST = 71680, SC_VEC = 106496, SC_QT = 108032;
DI void scan_phase(unsigned char* sl, int layer, bool ctx_out, bool do_store, LAS unsigned char* lds) {
    const int wg = blockIdx.x; if (wg >= 128) return;
    const int tid = opaque_tid(), lane = tid & 63, wid = __builtin_amdgcn_readfirstlane(tid >> 6), r32 = lane & 31, hh = lane >> 5;
    const int dir = wg & 1, h = (wg >> 1) & 7, b = wg >> 4;
    const bf16_t* Qs = (const bf16_t*)(sl + 1 * SLAB); bf16_t* Gs = (bf16_t*)(sl + (size_t)(2 + dir) * SLAB); const bf16_t* Vs = (const bf16_t*)(sl + 4 * SLAB);
    const int kp = tid & 63, oct = tid >> 6;
    const size_t colp = (size_t)h * 128 + 2 * kp;
    f32x16 sacc[2];
#pragma unroll
    for (int t = 0; t < 2; ++t)
#pragma unroll
        for (int i = 0; i < 16; ++i) sacc[t][i] = 0.f;
    const int vb = wid & 3, kb0 = 2 * (wid >> 2), tb = wid >> 2;
    LAS float* vec = (LAS float*)(lds + SC_VEC); LAS float* qt = (LAS float*)(lds + SC_QT);
#define SC_ROW0(ci_) (((ci_) < 4) ? (b * TP + TL + 64 * (dir ? 3 - (ci_) : (ci_))) : (b * TP + 64 * (dir ? 63 - ((ci_) - 4) : ((ci_) - 4))))
#define SC_LOAD(r0_) do { _Pragma("unroll") for (int j = 0; j < 8; ++j) { const int tau = 8 * oct + j; const size_t ro = (size_t)((r0_) + (dir ? 63 - tau : tau)) * D + colp; \
            lw[j] = *(const unsigned*)(Gs + ro); qw[j] = *(const unsigned*)(Qs + ro); vw[j] = *(const unsigned*)(Vs + ro); } } while (0)
    unsigned lw[8], qw[8], vw[8];
    SC_LOAD(SC_ROW0(0));
    for (int ci = 0; ci < 68; ++ci) {
        const int row0 = SC_ROW0(ci); const bool need_out = (ci < 4) ? ctx_out : true;
        float c0 = 0.f, c1 = 0.f; float A0[8], A1[8];
#pragma unroll
        for (int j = 0; j < 8; ++j) { c0 += bflo(lw[j]); c1 += bfhi(lw[j]); A0[j] = c0; A1[j] = c1; }
        *(LAS f32x2_t*)(qt + oct * 128 + 2 * kp) = (f32x2_t){c0, c1};
        __syncthreads();
        float of0 = 0.f, of1 = 0.f, ar0 = 0.f, ar1 = 0.f, al0 = 0.f, al1 = 0.f;
#pragma unroll
        for (int o = 0; o < 8; ++o) { const f32x2_t tq = *(const LAS f32x2_t*)(qt + o * 128 + 2 * kp);
            if (o < oct) { of0 += tq.x; of1 += tq.y; } if (o < 4) { ar0 += tq.x; ar1 += tq.y; } al0 += tq.x; al1 += tq.y; }
        if (oct == 0) { *(LAS f32x2_t*)(vec + 2 * kp) = (f32x2_t){__expf(ar0), __expf(ar1)}; *(LAS f32x2_t*)(vec + 128 + 2 * kp) = (f32x2_t){__expf(al0), __expf(al1)};
            *(LAS f32x2_t*)(vec + 256 + 2 * kp) = (f32x2_t){__expf(al0 - ar0), __expf(al1 - ar1)}; }
        unsigned kt0[4], kt1[4];
        float kprev0 = 0.f, kprev1 = 0.f;
#pragma unroll
        for (int j = 0; j < 8; ++j) {
            const float a0 = of0 + A0[j], a1 = of1 + A1[j];
            const float l0 = bflo(lw[j]), l1 = bfhi(lw[j]);
            const float qh0 = bflo(qw[j]) * __expf(fminf(a0 - ar0, 80.f)), qh1 = bfhi(qw[j]) * __expf(fminf(a1 - ar1, 80.f));
            const float kh0 = (1.f - __expf(l0)) * __expf(fminf(ar0 - a0, 80.f)), kh1 = (1.f - __expf(l1)) * __expf(fminf(ar1 - a1, 80.f));
            const int tau = 8 * oct + j;
            *(LAS unsigned*)(lds + SC_QH + tau * 272 + kp * 4) = cvtpk(qh0, qh1);
            *(LAS unsigned*)(lds + SC_KH + tau * 272 + kp * 4) = cvtpk(kh0, kh1);
            if (j & 1) { kt0[j >> 1] = cvtpk(kprev0, kh0); kt1[j >> 1] = cvtpk(kprev1, kh1); } else { kprev0 = kh0; kprev1 = kh1; }
        }
        *(LAS u32x4*)(lds + SC_KT + (2 * kp) * 144 + oct * 16) = (u32x4){kt0[0], kt0[1], kt0[2], kt0[3]};
        *(LAS u32x4*)(lds + SC_KT + (2 * kp + 1) * 144 + oct * 16) = (u32x4){kt1[0], kt1[1], kt1[2], kt1[3]};
        { u32x4 v0, v1;
#pragma unroll
          for (int e = 0; e < 4; ++e) { v0[e] = (vw[2 * e] & 0xffffu) | (vw[2 * e + 1] << 16); v1[e] = (vw[2 * e] >> 16) | (vw[2 * e + 1] & 0xffff0000u); }
          *(LAS u32x4*)(lds + SC_VT + (2 * kp) * 144 + oct * 16) = v0; *(LAS u32x4*)(lds + SC_VT + (2 * kp + 1) * 144 + oct * 16) = v1; }
        if (ci + 1 < 68) SC_LOAD(SC_ROW0(ci + 1));
        __syncthreads();
#pragma unroll
        for (int t = 0; t < 2; ++t)
#pragma unroll
            for (int g = 0; g < 4; ++g) { const int k0 = 32 * (kb0 + t) + 8 * g + 4 * hh; const f32x4 ea = *(const LAS f32x4*)(vec + k0);
                u32x2 w; w.x = cvtpk(sacc[t][4 * g] * ea[0], sacc[t][4 * g + 1] * ea[1]); w.y = cvtpk(sacc[t][4 * g + 2] * ea[2], sacc[t][4 * g + 3] * ea[3]);
                *(LAS u32x2*)(lds + SC_ST + (32 * vb + r32) * 272 + k0 * 2) = w; }
        __syncthreads();
        f32x16 d1[2];
#pragma unroll
        for (int t = 0; t < 2; ++t) {
#pragma unroll
            for (int i = 0; i < 16; ++i) d1[t][i] = 0.f;
#pragma unroll
            for (int s = 0; s < 4; ++s) { const bf16x8 af = *(const LAS bf16x8*)(lds + SC_KT + (32 * (kb0 + t) + r32) * 144 + (16 * s + 8 * hh) * 2);
                const bf16x8 bfv = *(const LAS bf16x8*)(lds + SC_VT + (32 * vb + r32) * 144 + (16 * s + 8 * hh) * 2);
                d1[t] = MFMA32(af, bfv, d1[t]); }
        }
        if (need_out) {
            f32x16 o, p0, p1;
#pragma unroll
            for (int i = 0; i < 16; ++i) { o[i] = 0.f; p0[i] = 0.f; p1[i] = 0.f; }
            bf16x8 qf[8];
#pragma unroll
            for (int s = 0; s < 8; ++s) qf[s] = *(const LAS bf16x8*)(lds + SC_QH + (32 * tb + r32) * 272 + (16 * s + 8 * hh) * 2);
            if (tb == 1) {
#pragma unroll
                for (int s = 0; s < 8; ++s) { const bf16x8 sf = *(const LAS bf16x8*)(lds + SC_ST + (32 * vb + r32) * 272 + (16 * s + 8 * hh) * 2);
                    const bf16x8 k0 = *(const LAS bf16x8*)(lds + SC_KH + r32 * 272 + (16 * s + 8 * hh) * 2), k1 = *(const LAS bf16x8*)(lds + SC_KH + (32 + r32) * 272 + (16 * s + 8 * hh) * 2);
                    o = MFMA32(sf, qf[s], o); p0 = MFMA32(k0, qf[s], p0); p1 = MFMA32(k1, qf[s], p1); }
#pragma unroll
                for (int i = 0; i < 16; ++i) if (crow(i, hh) > r32) p1[i] = 0.f;
            } else {
#pragma unroll
                for (int s = 0; s < 8; ++s) { const bf16x8 sf = *(const LAS bf16x8*)(lds + SC_ST + (32 * vb + r32) * 272 + (16 * s + 8 * hh) * 2);
                    const bf16x8 k0 = *(const LAS bf16x8*)(lds + SC_KH + r32 * 272 + (16 * s + 8 * hh) * 2);
                    o = MFMA32(sf, qf[s], o); p0 = MFMA32(k0, qf[s], p0); }
#pragma unroll
                for (int i = 0; i < 16; ++i) if (crow(i, hh) > r32) p0[i] = 0.f;
            }
#define SC_PV(PT, SB) do { _Pragma("unroll") for (int s = 0; s < 2; ++s) { \
                    u32x4 pa; pa.x = cvtpk(PT[8 * s], PT[8 * s + 1]); pa.y = cvtpk(PT[8 * s + 2], PT[8 * s + 3]); pa.z = cvtpk(PT[8 * s + 4], PT[8 * s + 5]); pa.w = cvtpk(PT[8 * s + 6], PT[8 * s + 7]); \
                    const u32x2 lo = *(const LAS u32x2*)(lds + SC_VT + (32 * vb + r32) * 144 + (32 * (SB) + 16 * s + 4 * hh) * 2); \
                    const u32x2 hi = *(const LAS u32x2*)(lds + SC_VT + (32 * vb + r32) * 144 + (32 * (SB) + 16 * s + 8 + 4 * hh) * 2); \
                    const u32x4 vbv = {lo.x, lo.y, hi.x, hi.y}; \
                    o = MFMA32(__builtin_bit_cast(bf16x8, vbv), __builtin_bit_cast(bf16x8, pa), o); } } while (0)
            SC_PV(p0, 0);
            if (tb == 1) SC_PV(p1, 1);
#undef SC_PV
            { const int tau = 32 * tb + r32; const size_t ro = (size_t)(row0 + (dir ? 63 - tau : tau)) * D + h * 128 + 32 * vb + 4 * hh;
#pragma unroll
              for (int g4 = 0; g4 < 4; ++g4) { u32x2 w; w.x = cvtpk(o[4 * g4], o[4 * g4 + 1]); w.y = cvtpk(o[4 * g4 + 2], o[4 * g4 + 3]);
                  if (do_store) *(u32x2*)(Gs + ro + 8 * g4) = w; } }
        }
#pragma unroll
        for (int t = 0; t < 2; ++t)
#pragma unroll
            for (int g = 0; g < 4; ++g) { const int k0 = 32 * (kb0 + t) + 8 * g + 4 * hh; const f32x4 aS = *(const LAS f32x4*)(vec + 128 + k0), bS = *(const LAS f32x4*)(vec + 256 + k0);
#pragma unroll
                for (int e = 0; e < 4; ++e) sacc[t][4 * g + e] = aS[e] * sacc[t][4 * g + e] + bS[e] * d1[t][4 * g + e]; }
        __syncthreads();
    }
}

DI void combine_phase(unsigned char* sl, const float* gnorm, bool skipctx, int NGW) {
    const int tid = opaque_tid(), lane = tid & 63; const int gw = blockIdx.x * NWAVES + __builtin_amdgcn_readfirstlane(tid >> 6);
    const bf16_t* Of = (const bf16_t*)(sl + 2 * SLAB); const bf16_t* Ob = (const bf16_t*)(sl + 3 * SLAB); const bf16_t* Hg = (const bf16_t*)(sl + 5 * SLAB); bf16_t* Y = (bf16_t*)(sl + 1 * SLAB);
    const int c16 = (lane & 7) * 16;
    float g[16];
#pragma unroll
    for (int i = 0; i < 16; ++i) g[i] = gnorm[c16 + i];
    int r = gw;
    if (skipctx) { while (r < M && (r % TP) >= TL) r += NGW; }
    u32x4 na0, na1, nb0, nb1, nh0, nh1;
#define CB_LOAD(rr) do { const size_t o_ = (size_t)(rr) * D + lane * 16; na0 = *(const u32x4*)(Of + o_); na1 = *(const u32x4*)(Of + o_ + 8); nb0 = *(const u32x4*)(Ob + o_); nb1 = *(const u32x4*)(Ob + o_ + 8); nh0 = *(const u32x4*)(Hg + o_); nh1 = *(const u32x4*)(Hg + o_ + 8); } while (0)
    if (r < M) CB_LOAD(r);
    while (r < M) {
        const size_t off = (size_t)r * D + lane * 16;
        const u32x4 a0 = na0, a1 = na1, b0 = nb0, b1 = nb1, h0 = nh0, h1 = nh1;
        int rn = r + NGW;
        if (skipctx) { while (rn < M && (rn % TP) >= TL) rn += NGW; }
        if (rn < M) CB_LOAD(rn);
        float o[16], hg[16];
#pragma unroll
        for (int i = 0; i < 4; ++i) { o[2 * i] = bflo(a0[i]) + bflo(b0[i]); o[2 * i + 1] = bfhi(a0[i]) + bfhi(b0[i]); o[8 + 2 * i] = bflo(a1[i]) + bflo(b1[i]); o[8 + 2 * i + 1] = bfhi(a1[i]) + bfhi(b1[i]);
            hg[2 * i] = bflo(h0[i]); hg[2 * i + 1] = bfhi(h0[i]); hg[8 + 2 * i] = bflo(h1[i]); hg[8 + 2 * i + 1] = bfhi(h1[i]); }
        float ss = 0.f;
#pragma unroll
        for (int i = 0; i < 16; ++i) ss += o[i] * o[i];
        ss += __shfl_xor(ss, 1); ss += __shfl_xor(ss, 2); ss += __shfl_xor(ss, 4);
        const float rs = rsqrtf(ss * (1.f / 128.f) + EPS);
        u32x4 w0, w1;
#pragma unroll
        for (int i = 0; i < 4; ++i) { w0[i] = cvtpk(o[2 * i] * rs * g[2 * i] * hg[2 * i], o[2 * i + 1] * rs * g[2 * i + 1] * hg[2 * i + 1]);
            w1[i] = cvtpk(o[8 + 2 * i] * rs * g[8 + 2 * i] * hg[8 + 2 * i], o[8 + 2 * i + 1] * rs * g[8 + 2 * i + 1] * hg[8 + 2 * i + 1]); }
        *(u32x4*)(Y + off) = w0; *(u32x4*)(Y + off + 8) = w1;
        r = rn;
    }
#undef CB_LOAD
}

constexpr int AT_KP = 144, AT_VP = 320, AT_KB = 2 * 64 * AT_KP, AT_BUF = AT_KB + 64 * AT_VP;
DI void attn_unit(const bf16_t* Q, const bf16_t* Kp, const bf16_t* Vp, bf16_t* O, size_t qrow0, size_t krow0, int ntile, int h, float lam, float lam_init, const float* gsub, LAS unsigned char* lds) {
    const int tid = opaque_tid(), lane = tid & 63, wid = __builtin_amdgcn_readfirstlane(tid >> 6), r32 = lane & 31, hh = lane >> 5;
    const int sub = wid & 1, qg = wid >> 1;
    constexpr int KRING = 0, VRING = 65536, SLOT = 16384;
    bf16x8 qf[4];
    { const bf16_t* qp = Q + (qrow0 + 32 * qg + r32) * D + h * 128 + sub * 64 + 8 * hh;
#pragma unroll
      for (int d0 = 0; d0 < 4; ++d0) qf[d0] = *(const bf16x8*)(qp + 16 * d0); }
    f32x16 ot[4];
#pragma unroll
    for (int d = 0; d < 4; ++d)
#pragma unroll
        for (int i = 0; i < 16; ++i) ot[d][i] = 0.f;
    float m_run = -1e30f, l_run = 0.f;
    const char* kbu = (const char*)(Kp + krow0 * D + h * 128); const char* vbu = (const char*)(Vp + krow0 * D + h * 128);
    unsigned kso, vso0, vso1;
    { const int kr = 8 * wid + (lane >> 3); const int kc = (lane & 7) ^ ((kr >> 1) & 7); kso = (unsigned)((kr * D + kc * 8) * 2);
      const int vr0 = 4 * wid + (lane >> 4), vr1 = vr0 + 32; const int vc = (lane & 15) ^ (4 * (vr0 & 3));
      vso0 = (unsigned)((vr0 * D + vc * 8) * 2); vso1 = (unsigned)((vr1 * D + vc * 8) * 2); }
    const unsigned ldsb = (unsigned)(unsigned long)lds;
#define AT_DMA(gp, ldsoff) do { unsigned keep_; const unsigned dst_ = (unsigned)__builtin_amdgcn_readfirstlane((int)(ldsb + (unsigned)(ldsoff))); \
        asm volatile("s_mov_b32 %0, m0\n\ts_mov_b32 m0, %2\n\ts_nop 0\n\tglobal_load_lds_dwordx4 %1, off\n\ts_mov_b32 m0, %0" : "=&s"(keep_) : "v"(gp), "s"(dst_) : "memory"); } while (0)
#define AT_ISSUE_K(tile, slot) do { const char* g_ = kbu + (size_t)(tile) * (64 * D * 2) + kso; AT_DMA(g_, KRING + (slot) * SLOT + wid * 1024); AT_DMA(g_ + 128, KRING + (slot) * SLOT + 8192 + wid * 1024); } while (0)
#define AT_ISSUE_V(tile, slot) do { const char* g_ = vbu + (size_t)(tile) * (64 * D * 2); AT_DMA(g_ + vso0, VRING + (slot) * SLOT + wid * 1024); AT_DMA(g_ + vso1, VRING + (slot) * SLOT + 8192 + wid * 1024); } while (0)
    asm volatile("s_waitcnt lgkmcnt(0)" ::: "memory"); __builtin_amdgcn_s_barrier();
    AT_ISSUE_K(0, 0); AT_ISSUE_K(1, 1); AT_ISSUE_K(2, 2); AT_ISSUE_K(3, 3); AT_ISSUE_V(0, 0); AT_ISSUE_V(1, 1);
    { const u32x4 z = {0u, 0u, 0u, 0u}; *(LAS u32x4*)(lds + VRING + 3 * SLOT + tid * 16) = z; *(LAS u32x4*)(lds + VRING + 3 * SLOT + 8192 + tid * 16) = z; }
    asm volatile("s_waitcnt vmcnt(0) lgkmcnt(0)" ::: "memory"); __builtin_amdgcn_s_barrier(); asm volatile("" ::: "memory");
    const int q4 = (lane & 15) >> 2, p4 = lane & 3, blk = (lane >> 4) & 1;
    const int ksw = (r32 >> 1) & 7;
    const int kro = sub * 8192 + r32 * 128;
    const int vro = (4 * hh + q4) * 256 + blk * 32 + p4 * 8;
    f32x16 sc[2], sn[2];
#pragma unroll
    for (int kh = 0; kh < 2; ++kh) {
#pragma unroll
        for (int i = 0; i < 16; ++i) sc[kh][i] = 0.f;
#pragma unroll
        for (int d0 = 0; d0 < 4; ++d0) { const bf16x8 kf = *(const LAS bf16x8*)(lds + KRING + kro + kh * 4096 + (((2 * d0 + hh) ^ ksw) * 16)); sc[kh] = MFMA32(kf, qf[d0], sc[kh]); }
    }
    u32x4 pp[4];
#pragma unroll
    for (int j = 0; j < 4; ++j) pp[j] = (u32x4){0u, 0u, 0u, 0u};
    constexpr float AT_TRIG = 16384.f;
    f32x16 negm;
    { float mx = fmaxf(fmaxf(sc[0][0], sc[0][1]), sc[0][2]);
#pragma unroll
      for (int i = 3; i < 15; i += 2) mx = fmaxf(fmaxf(mx, sc[0][i]), sc[0][i + 1]);
      mx = fmaxf(mx, sc[0][15]);
#pragma unroll
      for (int i = 0; i < 16; i += 2) mx = fmaxf(fmaxf(mx, sc[1][i]), sc[1][i + 1]);
      mx = fmaxf(mx, __shfl_xor(mx, 32));
#pragma unroll
      for (int i = 0; i < 16; ++i) { negm[i] = -mx; sc[0][i] -= mx; sc[1][i] -= mx; } }
    asm volatile("s_waitcnt lgkmcnt(0)" ::: "memory"); __builtin_amdgcn_s_barrier(); asm volatile("" ::: "memory");
    const bool shifted = wid >= 4;
    float ps = 0.f;
    if (shifted) {
#pragma unroll
        for (int kh = 0; kh < 2; ++kh)
#pragma unroll
            for (int i = 0; i < 16; ++i) { sc[kh][i] = __builtin_amdgcn_exp2f(sc[kh][i]); ps += sc[kh][i]; }
        l_run += ps;
    }
    int ks0 = 0, ks1 = 1, vsm1 = 3, vs1 = 2;
    for (int t = 0; t < ntile; t += 2) {
      {
        { const int tk = (t + 4 < ntile) ? t + 4 : ntile - 1; AT_ISSUE_K(tk, ks0); const int tv = (t + 2 < ntile) ? t + 2 : ntile - 1; AT_ISSUE_V(tv, vs1); }
        LAS unsigned char* kb = lds + KRING + ks1 * SLOT + kro;
        LAS unsigned char* vb = lds + VRING + vsm1 * SLOT + vro;
        __builtin_amdgcn_s_setprio(1);
        { bf16x8 ql[4];
#pragma unroll
          for (int d0 = 0; d0 < 4; ++d0) ql[d0] = qf[d0];
#pragma unroll
          for (int kh = 0; kh < 2; ++kh) {
            bf16x8 kf[4];
#pragma unroll
            for (int e = 0; e < 4; ++e) kf[e] = *(const LAS bf16x8*)(kb + kh * 4096 + (((2 * e + hh) ^ ksw) * 16));
            sn[kh] = MFMA32(kf[0], ql[0], negm);
#pragma unroll
            for (int d0 = 1; d0 < 4; ++d0) sn[kh] = MFMA32(kf[d0], ql[d0], sn[kh]);
            __builtin_amdgcn_sched_barrier(0);
          } }
#pragma unroll
        for (int j = 0; j < 4; ++j) {
            s16x4 lo[4], hi[4];
#pragma unroll
            for (int e = 0; e < 4; ++e) { LAS unsigned char* vp = vb + j * 4096 + ((e ^ q4) * 64);
                lo[e] = __builtin_bit_cast(s16x4, __builtin_amdgcn_ds_read_tr16_b64_v4i16((LAS s16x4*)vp));
                hi[e] = __builtin_bit_cast(s16x4, __builtin_amdgcn_ds_read_tr16_b64_v4i16((LAS s16x4*)(vp + 2048))); }
#pragma unroll
            for (int e = 0; e < 4; ++e) ot[e] = MFMA32(__builtin_shufflevector(lo[e], hi[e], 0, 1, 2, 3, 4, 5, 6, 7), __builtin_bit_cast(bf16x8, pp[j]), ot[e]);
            __builtin_amdgcn_sched_barrier(0);
        }
        __builtin_amdgcn_s_setprio(0);
        if (!shifted) {
            ps = 0.f;
#pragma unroll
            for (int kh = 0; kh < 2; ++kh)
#pragma unroll
                for (int i = 0; i < 16; ++i) { sc[kh][i] = __builtin_amdgcn_exp2f(sc[kh][i]); ps += sc[kh][i]; }
            l_run += ps;
        }
        if (__builtin_amdgcn_ballot_w64(ps > AT_TRIG) != 0ull) {
            float pm = fmaxf(fmaxf(sc[0][0], sc[0][1]), sc[0][2]);
#pragma unroll
            for (int i = 3; i < 15; i += 2) pm = fmaxf(fmaxf(pm, sc[0][i]), sc[0][i + 1]);
            pm = fmaxf(pm, sc[0][15]);
#pragma unroll
            for (int i = 0; i < 16; i += 2) pm = fmaxf(fmaxf(pm, sc[1][i]), sc[1][i + 1]);
            pm = fmaxf(pm, __shfl_xor(pm, 32));
            const bool mv = pm > 256.f; const float delta = mv ? __builtin_amdgcn_logf(pm) : 0.f; const float alpha = mv ? __builtin_amdgcn_rcpf(pm) : 1.f;
            l_run *= alpha;
#pragma unroll
            for (int i = 0; i < 16; ++i) negm[i] -= delta;
#pragma unroll
            for (int kh = 0; kh < 2; ++kh)
#pragma unroll
                for (int i = 0; i < 16; ++i) { sc[kh][i] *= alpha; sn[kh][i] -= delta; }
#pragma unroll
            for (int d = 0; d < 4; ++d)
#pragma unroll
                for (int i = 0; i < 16; ++i) ot[d][i] *= alpha;
        }
#pragma unroll
        for (int kh = 0; kh < 2; ++kh)
#pragma unroll
            for (int s2 = 0; s2 < 2; ++s2) { u32x4 pa; pa.x = cvtpk(sc[kh][8 * s2], sc[kh][8 * s2 + 1]); pa.y = cvtpk(sc[kh][8 * s2 + 2], sc[kh][8 * s2 + 3]); pa.z = cvtpk(sc[kh][8 * s2 + 4], sc[kh][8 * s2 + 5]); pa.w = cvtpk(sc[kh][8 * s2 + 6], sc[kh][8 * s2 + 7]);
                pp[2 * kh + s2] = pa; }
        { const int n0 = ks1; ks1 = (ks1 + 1) & 3; ks0 = n0; vsm1 = (vsm1 + 1) & 3; vs1 = (vs1 + 1) & 3; }
        asm volatile("s_waitcnt vmcnt(8) lgkmcnt(0)" ::: "memory"); __builtin_amdgcn_s_barrier(); asm volatile("" ::: "memory");
        if (shifted && t + 1 < ntile) {
            ps = 0.f;
#pragma unroll
            for (int kh = 0; kh < 2; ++kh)
#pragma unroll
                for (int i = 0; i < 16; ++i) { sn[kh][i] = __builtin_amdgcn_exp2f(sn[kh][i]); ps += sn[kh][i]; }
            l_run += ps;
        }
          }
      {
        const int t1 = t + 1;
        { const int tk = (t1 + 4 < ntile) ? t1 + 4 : ntile - 1; AT_ISSUE_K(tk, ks0); const int tv = (t1 + 2 < ntile) ? t1 + 2 : ntile - 1; AT_ISSUE_V(tv, vs1); }
        LAS unsigned char* kb = lds + KRING + ks1 * SLOT + kro;
        LAS unsigned char* vb = lds + VRING + vsm1 * SLOT + vro;
        __builtin_amdgcn_s_setprio(1);
        { bf16x8 ql[4];
#pragma unroll
          for (int d0 = 0; d0 < 4; ++d0) ql[d0] = qf[d0];
#pragma unroll
          for (int kh = 0; kh < 2; ++kh) {
            bf16x8 kf[4];
#pragma unroll
            for (int e = 0; e < 4; ++e) kf[e] = *(const LAS bf16x8*)(kb + kh * 4096 + (((2 * e + hh) ^ ksw) * 16));
            sc[kh] = MFMA32(kf[0], ql[0], negm);
#pragma unroll
            for (int d0 = 1; d0 < 4; ++d0) sc[kh] = MFMA32(kf[d0], ql[d0], sc[kh]);
            __builtin_amdgcn_sched_barrier(0);
          } }
#pragma unroll
        for (int j = 0; j < 4; ++j) {
            s16x4 lo[4], hi[4];
#pragma unroll
            for (int e = 0; e < 4; ++e) { LAS unsigned char* vp = vb + j * 4096 + ((e ^ q4) * 64);
                lo[e] = __builtin_bit_cast(s16x4, __builtin_amdgcn_ds_read_tr16_b64_v4i16((LAS s16x4*)vp));
                hi[e] = __builtin_bit_cast(s16x4, __builtin_amdgcn_ds_read_tr16_b64_v4i16((LAS s16x4*)(vp + 2048))); }
#pragma unroll
            for (int e = 0; e < 4; ++e) ot[e] = MFMA32(__builtin_shufflevector(lo[e], hi[e], 0, 1, 2, 3, 4, 5, 6, 7), __builtin_bit_cast(bf16x8, pp[j]), ot[e]);
            __builtin_amdgcn_sched_barrier(0);
        }
        __builtin_amdgcn_s_setprio(0);
        if (!shifted) {
            ps = 0.f;
#pragma unroll
            for (int kh = 0; kh < 2; ++kh)
#pragma unroll
                for (int i = 0; i < 16; ++i) { sn[kh][i] = __builtin_amdgcn_exp2f(sn[kh][i]); ps += sn[kh][i]; }
            l_run += ps;
        }
        if (__builtin_amdgcn_ballot_w64(ps > AT_TRIG) != 0ull) {
            float pm = fmaxf(fmaxf(sn[0][0], sn[0][1]), sn[0][2]);
#pragma unroll
            for (int i = 3; i < 15; i += 2) pm = fmaxf(fmaxf(pm, sn[0][i]), sn[0][i + 1]);
            pm = fmaxf(pm, sn[0][15]);
#pragma unroll
            for (int i = 0; i < 16; i += 2) pm = fmaxf(fmaxf(pm, sn[1][i]), sn[1][i + 1]);
            pm = fmaxf(pm, __shfl_xor(pm, 32));
            const bool mv = pm > 256.f; const float delta = mv ? __builtin_amdgcn_logf(pm) : 0.f; const float alpha = mv ? __builtin_amdgcn_rcpf(pm) : 1.f;
            l_run *= alpha;
#pragma unroll
            for (int i = 0; i < 16; ++i) negm[i] -= delta;
#pragma unroll
            for (int kh = 0; kh < 2; ++kh)
#pragma unroll
                for (int i = 0; i < 16; ++i) { sn[kh][i] *= alpha; sc[kh][i] -= delta; }
#pragma unroll
            for (int d = 0; d < 4; ++d)
#pragma unroll
                for (int i = 0; i < 16; ++i) ot[d][i] *= alpha;
        }
#pragma unroll
        for (int kh = 0; kh < 2; ++kh)
#pragma unroll
            for (int s2 = 0; s2 < 2; ++s2) { u32x4 pa; pa.x = cvtpk(sn[kh][8 * s2], sn[kh][8 * s2 + 1]); pa.y = cvtpk(sn[kh][8 * s2 + 2], sn[kh][8 * s2 + 3]); pa.z = cvtpk(sn[kh][8 * s2 + 4], sn[kh][8 * s2 + 5]); pa.w = cvtpk(sn[kh][8 * s2 + 6], sn[kh][8 * s2 + 7]);
                pp[2 * kh + s2] = pa; }
        { const int n0 = ks1; ks1 = (ks1 + 1) & 3; ks0 = n0; vsm1 = (vsm1 + 1) & 3; vs1 = (vs1 + 1) & 3; }
        asm volatile("s_waitcnt vmcnt(8) lgkmcnt(0)" ::: "memory"); __builtin_amdgcn_s_barrier(); asm volatile("" ::: "memory");
        if (shifted && t1 + 1 < ntile) {
            ps = 0.f;
#pragma unroll
            for (int kh = 0; kh < 2; ++kh)
#pragma unroll
                for (int i = 0; i < 16; ++i) { sc[kh][i] = __builtin_amdgcn_exp2f(sc[kh][i]); ps += sc[kh][i]; }
            l_run += ps;
        }
          }
    }
    { LAS unsigned char* vb = lds + VRING + vsm1 * SLOT + vro;
#pragma unroll
      for (int j = 0; j < 4; ++j) {
          s16x4 lo[4], hi[4];
#pragma unroll
          for (int e = 0; e < 4; ++e) { LAS unsigned char* vp = vb + j * 4096 + ((e ^ q4) * 64);
              lo[e] = __builtin_bit_cast(s16x4, __builtin_amdgcn_ds_read_tr16_b64_v4i16((LAS s16x4*)vp));
              hi[e] = __builtin_bit_cast(s16x4, __builtin_amdgcn_ds_read_tr16_b64_v4i16((LAS s16x4*)(vp + 2048))); }
#pragma unroll
          for (int e = 0; e < 4; ++e) ot[e] = MFMA32(__builtin_shufflevector(lo[e], hi[e], 0, 1, 2, 3, 4, 5, 6, 7), __builtin_bit_cast(bf16x8, pp[j]), ot[e]);
      } }
#undef AT_DMA
#undef AT_ISSUE_K
#undef AT_ISSUE_V
    asm volatile("s_waitcnt vmcnt(0) lgkmcnt(0)" ::: "memory"); __builtin_amdgcn_s_barrier(); asm volatile("" ::: "memory");
    l_run += __shfl_xor(l_run, 32);
    const float inv = 1.f / l_run;
    LAS float* xch = (LAS float*)lds + qg * 4096;
    if (sub == 1) {
#pragma unroll
        for (int d = 0; d < 4; ++d)
#pragma unroll
            for (int i = 0; i < 16; ++i) xch[(d * 16 + i) * 64 + lane] = ot[d][i] * inv * lam;
    }
    __syncthreads();
    if (sub == 0) {
        float ss = 0.f;
#pragma unroll
        for (int d = 0; d < 4; ++d)
#pragma unroll
            for (int i = 0; i < 16; ++i) { const float v = ot[d][i] * inv - xch[(d * 16 + i) * 64 + lane]; ot[d][i] = v; ss += v * v; }
        ss += __shfl_xor(ss, 32);
        const float rs = rsqrtf(ss * (1.f / 128.f) + EPS) * (1.f - lam_init);
        bf16_t* op = O + (qrow0 + 32 * qg + r32) * D + h * 128;
#pragma unroll
        for (int d = 0; d < 4; ++d)
#pragma unroll
            for (int g = 0; g < 4; ++g) { const int dv = 32 * d + 8 * g + 4 * hh; const f32x4 gg = *(const f32x4*)(gsub + dv);
                u32x2 w; w.x = cvtpk(ot[d][4 * g] * rs * gg[0], ot[d][4 * g + 1] * rs * gg[1]); w.y = cvtpk(ot[d][4 * g + 2] * rs * gg[2], ot[d][4 * g + 3] * rs * gg[3]);
                *(u32x2*)(op + dv) = w; }
    }
}
DI void attn_phase(unsigned char* sl, bf16_t* O, int layer, bool ctx_out, const float* lamtab, const float* gsub, LAS unsigned char* lds, bool qsplit) {
    const bf16_t* Q = (const bf16_t*)(sl + 2 * SLAB); const bf16_t* Kp = (const bf16_t*)(sl + 3 * SLAB); const bf16_t* Vp = (const bf16_t*)(sl + 4 * SLAB);
    const float lam = lamtab[layer], lam_init = lamtab[2 + layer];
    const int G = gridDim.x; const int vcu = WG_BLOCKED();
    const int nlat = NB * 8 * 32, ntot = nlat + (ctx_out ? NB * 8 * 2 : 0);
    for (int u = vcu; u < ntot; u += G) {
        if (u < nlat) { const int qb = u & 31, bh = u >> 5, h = bh & 7, b = bh >> 3;
            const size_t q0 = (size_t)b * TP + 128 * qb;
            attn_unit((qsplit && q0 < (size_t)PMQ * 256) ? (const bf16_t*)(sl + 6 * SLAB) : Q, Kp, Vp, O, q0, (size_t)b * TP, TP / 64, h, lam, lam_init, gsub, lds); }
        else { const int v = u - nlat; const int qb = v & 1, bh = v >> 1, h = bh & 7, b = bh >> 3;
            const size_t q0 = (size_t)b * TP + TL + 128 * qb;
            attn_unit((qsplit && q0 < (size_t)PMQ * 256) ? (const bf16_t*)(sl + 6 * SLAB) : Q, Kp, Vp, O, q0, (size_t)b * TP + TL, LC / 64, h, lam, lam_init, gsub, lds); }
    }
}

DI void gmlp_phase(unsigned char* sl, const float* ln_g, const float* ln_b, const float* ws_, const float* bs_, bool skipctx, LAS unsigned char* lds) {
    bf16_t* GU = (bf16_t*)(sl + 3 * SLAB); const bf16_t* GV = (const bf16_t*)(sl + 4 * SLAB);
    const int tid = opaque_tid(), lane = tid & 63, wid = __builtin_amdgcn_readfirstlane(tid >> 6), r32 = lane & 31, hh = lane >> 5;
    LAS float* stat = (LAS float*)(lds + 40960);
    const int nitem = NB * 34 * 8;
    for (int it = blockIdx.x; it < nitem; it += gridDim.x) {
        const int g = it & 7, cidx = it >> 3, b = cidx / 34, cc = cidx % 34;
        if (skipctx && cc >= 32) continue;
        const size_t r0 = (size_t)b * TP + 128 * cc;
        __syncthreads();
        if (tid < 128) { const f32x4* pp_ = (const f32x4*)((const float*)(sl + 5 * SLAB) + (r0 + tid) * 32); float sm = 0.f, sq = 0.f;
#pragma unroll
            for (int i = 0; i < 8; ++i) { const f32x4 v = pp_[i]; sm += v[0] + v[2]; sq += v[1] + v[3]; }
            const float mu = sm * (1.f / 1024.f); const float var = fmaxf(sq * (1.f / 1024.f) - mu * mu, 0.f);
            stat[2 * tid] = mu; stat[2 * tid + 1] = rsqrtf(var + EPS); }
        __syncthreads();
        { const int s = tid >> 2, qd = tid & 3; const bf16_t* rp = GV + (r0 + s) * D + g * 128 + qd * 32; const float mu = stat[2 * s], rs = stat[2 * s + 1];
#pragma unroll
          for (int i = 0; i < 4; ++i) { const u32x4 w = *(const u32x4*)(rp + 8 * i);
              const int cb_ = g * 128 + qd * 32 + 8 * i; const f32x4 lg0 = *(const f32x4*)(ln_g + cb_), lg1 = *(const f32x4*)(ln_g + cb_ + 4), lb0 = *(const f32x4*)(ln_b + cb_), lb1 = *(const f32x4*)(ln_b + cb_ + 4);
#pragma unroll
              for (int e = 0; e < 4; ++e) { const int c = qd * 32 + 8 * i + 2 * e;
                  const float ga = (e < 2) ? lg0[2 * e] : lg1[2 * e - 4], gb = (e < 2) ? lg0[2 * e + 1] : lg1[2 * e - 3], ba = (e < 2) ? lb0[2 * e] : lb1[2 * e - 4], bb = (e < 2) ? lb0[2 * e + 1] : lb1[2 * e - 3];
                  const float v0 = (bflo(w[e]) - mu) * rs * ga + ba, v1 = (bfhi(w[e]) - mu) * rs * gb + bb;
                  *(LAS unsigned short*)(lds + c * 272 + s * 2) = f2bf(v0); *(LAS unsigned short*)(lds + (c + 1) * 272 + s * 2) = f2bf(v1); } } }
        __syncthreads();
        const int tb = wid >> 1, cb0 = 2 * (wid & 1);
        f32x16 acc[2];
#pragma unroll
        for (int t = 0; t < 2; ++t)
#pragma unroll
            for (int i = 0; i < 16; ++i) acc[t][i] = 0.f;
        const float* wrow = ws_ + ((size_t)g * 128 + 32 * tb + r32) * 128 + 8 * hh;
#pragma unroll
        for (int s = 0; s < 8; ++s) { const f32x4 w0 = *(const f32x4*)(wrow + 16 * s), w1 = *(const f32x4*)(wrow + 16 * s + 4);
            u32x4 pa; pa.x = cvtpk(w0[0], w0[1]); pa.y = cvtpk(w0[2], w0[3]); pa.z = cvtpk(w1[0], w1[1]); pa.w = cvtpk(w1[2], w1[3]);
            const bf16x8 af = __builtin_bit_cast(bf16x8, pa);
#pragma unroll
            for (int t = 0; t < 2; ++t) { const bf16x8 bfv = *(const LAS bf16x8*)(lds + (32 * (cb0 + t) + r32) * 272 + (16 * s + 8 * hh) * 2); acc[t] = MFMA32(bfv, af, acc[t]); } }
        { const int tt = 32 * tb + r32; const float bias = bs_[g * 128 + tt];
#pragma unroll
          for (int t = 0; t < 2; ++t)
#pragma unroll
            for (int g4 = 0; g4 < 4; ++g4) { const size_t off = (r0 + tt) * D + g * 128 + 32 * (cb0 + t) + 8 * g4 + 4 * hh;
                const u32x2 gu = *(const u32x2*)(GU + off);
                u32x2 w; w.x = cvtpk(bflo(gu.x) * (acc[t][4 * g4] + bias), bfhi(gu.x) * (acc[t][4 * g4 + 1] + bias)); w.y = cvtpk(bflo(gu.y) * (acc[t][4 * g4 + 2] + bias), bfhi(gu.y) * (acc[t][4 * g4 + 3] + bias));
                *(u32x2*)(GU + off) = w; } }
    }
}

DI void act_phase(const bf16_t* U, bf16_t* ACT, const float* cw, const float* cb, int hf, bool skipctx, int ngt) {
    const int gtid = blockIdx.x * NTHR + opaque_tid();
    constexpr int NCH = DFFH / 8, NSTRIP = M / 16;
    for (int idx = gtid; idx < NSTRIP * NCH; idx += ngt) {
        const int strip = idx / NCH, ch = idx - strip * NCH; const int r0 = strip * 16; const int p0 = r0 % TP;
        if (skipctx && p0 >= TL) continue;
        const int c = ch * 8; const int ca = DFFH * hf + c, cbn = DFF + DFFH * hf + c;
        f32x4 wa[3][2], wb[3][2], ba[2], bb[2];
#pragma unroll
        for (int j = 0; j < 3; ++j) { wa[j][0] = *(const f32x4*)(cw + j * 2 * DFF + ca); wa[j][1] = *(const f32x4*)(cw + j * 2 * DFF + ca + 4); wb[j][0] = *(const f32x4*)(cw + j * 2 * DFF + cbn); wb[j][1] = *(const f32x4*)(cw + j * 2 * DFF + cbn + 4); }
        ba[0] = *(const f32x4*)(cb + ca); ba[1] = *(const f32x4*)(cb + ca + 4); bb[0] = *(const f32x4*)(cb + cbn); bb[1] = *(const f32x4*)(cb + cbn + 4);
        const bf16_t* up = U + (size_t)r0 * DFF + c; bf16_t* op = ACT + (size_t)r0 * DFF + DFFH * hf + c;
        const bool has_prev = (p0 != 0 && p0 != TL), has_next = (p0 + 16 != TL && p0 + 16 != TP);
        const u32x4 z = {0u, 0u, 0u, 0u};
        u32x4 a0 = has_prev ? *(const u32x4*)(up - DFF) : z, b0 = has_prev ? *(const u32x4*)(up - DFF + DFFH) : z;
        u32x4 a1 = *(const u32x4*)up, b1 = *(const u32x4*)(up + DFFH);
#pragma unroll 4
        for (int i = 0; i < 16; ++i) {
            const bool nx = (i < 15) || has_next;
            const u32x4 a2 = nx ? *(const u32x4*)(up + (size_t)(i + 1) * DFF) : z, b2 = nx ? *(const u32x4*)(up + (size_t)(i + 1) * DFF + DFFH) : z;
            u32x4 w;
#pragma unroll
            for (int e = 0; e < 4; ++e) {
                const int v = e >> 1, q0 = (2 * e) & 3, q1 = q0 + 1;
                const float av0 = wa[0][v][q0] * bflo(a0[e]) + wa[1][v][q0] * bflo(a1[e]) + wa[2][v][q0] * bflo(a2[e]) + ba[v][q0];
                const float av1 = wa[0][v][q1] * bfhi(a0[e]) + wa[1][v][q1] * bfhi(a1[e]) + wa[2][v][q1] * bfhi(a2[e]) + ba[v][q1];
                const float bv0 = wb[0][v][q0] * bflo(b0[e]) + wb[1][v][q0] * bflo(b1[e]) + wb[2][v][q0] * bflo(b2[e]) + bb[v][q0];
                const float bv1 = wb[0][v][q1] * bfhi(b0[e]) + wb[1][v][q1] * bfhi(b1[e]) + wb[2][v][q1] * bfhi(b2[e]) + bb[v][q1];
                w[e] = cvtpk(silu_f(av0) * bv0, silu_f(av1) * bv1);
            }
            *(u32x4*)(op + (size_t)i * DFF) = w;
            a0 = a1; a1 = a2; b0 = b1; b1 = b2;
        }
    }
}

#define XB_TMO      128
#define XB_XCNT(j)  (256  + 64 * (j))
#define XB_XSUB(j)  (1280 + 64 * (j))
#define XB_XGEN(j)  (2304 + 64 * (j))
#define XB_TOP      3328
#define XB_TOPGEN   3392
#define XCD_BAR_WORDS 3456
#define XB_SPIN_CAP (1u << 20)
DI unsigned xb_ld(unsigned* p)              { return __hip_atomic_load(p, __ATOMIC_RELAXED, __HIP_MEMORY_SCOPE_AGENT); }
DI unsigned xb_add(unsigned* p, unsigned v) { return __hip_atomic_fetch_add(p, v, __ATOMIC_RELAXED, __HIP_MEMORY_SCOPE_AGENT); }
DI unsigned xb_xcc_id() { return (unsigned)__builtin_amdgcn_s_getreg((3 << 11) | 20) & 0xFu; }
#define XB_SPIN(cond, bar) do { unsigned _sp = 0; while (cond) { __builtin_amdgcn_s_sleep(4); \
    if ((++_sp & 255u) == 0u) { if (xb_ld(&(bar)[XB_TMO])) break; if (_sp > XB_SPIN_CAP) { atomicAdd(&(bar)[XB_TMO], 1u); break; } } } } while (0)
struct XcdBarrier { unsigned* bar; unsigned x; volatile LAS unsigned* st; };
DI XcdBarrier xcd_barrier_post(unsigned* bar, volatile LAS unsigned* st) {
    XcdBarrier b; b.bar = bar; b.x = xb_xcc_id(); b.st = st;
    if (threadIdx.x == 0) { st[2] = xb_add(&bar[XB_XCNT(b.x)], 1u); st[3] = b.x; }
    return b;
}
DI void xcd_barrier_complete(unsigned* bar, unsigned x, unsigned& nloc, unsigned& nx) {
    const unsigned G = gridDim.x * gridDim.y * gridDim.z;
    unsigned sum, cnt, mine, sp = 0u;
    for (;;) {
        sum = 0u; cnt = 0u; mine = 0u;
#pragma unroll
        for (unsigned j = 0; j < 16; ++j) { const unsigned c = xb_ld(&bar[XB_XCNT(j)]); sum += c; cnt += (c > 0u) ? 1u : 0u; mine = (j == x) ? c : mine; }
        if (sum == G) break;
        __builtin_amdgcn_s_sleep(1);
        if ((++sp & 255u) == 0u) { if (xb_ld(&bar[XB_TMO])) break; if (sp > XB_SPIN_CAP) { atomicAdd(&bar[XB_TMO], 1u); break; } }
    }
    nloc = mine > 0u ? mine : 1u; nx = cnt > 0u ? cnt : 1u;
}
DI void xcd_barrier(const XcdBarrier& b) {
    asm volatile("s_waitcnt vmcnt(0)" ::: "memory");
    __syncthreads();
    if (threadIdx.x == 0) {
        unsigned* bar = b.bar;
        __builtin_amdgcn_s_waitcnt(0);
        unsigned nloc = b.st[0], nx = b.st[1];
        if (nloc == 0u) { xcd_barrier_complete(bar, b.x, nloc, nx); b.st[0] = nloc; b.st[1] = nx; }
        const unsigned old = xb_add(&bar[XB_XSUB(b.x)], 1u);
        const unsigned gen = old / nloc;
        if (old + 1u == (gen + 1u) * nloc) {
            __builtin_amdgcn_fence(__ATOMIC_RELEASE, "agent");
            asm volatile("s_waitcnt vmcnt(0)" ::: "memory");
            const unsigned og = xb_add(&bar[XB_TOP], 1u);
            const unsigned tg = og / nx;
            if (og + 1u == (tg + 1u) * nx) xb_add(&bar[XB_TOPGEN], 1u);
            else XB_SPIN(xb_ld(&bar[XB_TOPGEN]) == tg, bar);
            __builtin_amdgcn_fence(__ATOMIC_ACQUIRE, "agent");
            xb_add(&bar[XB_XGEN(b.x)], 1u);
            asm volatile("s_waitcnt vmcnt(0)" ::: "memory");
        } else {
            XB_SPIN(xb_ld(&bar[XB_XGEN(b.x)]) == gen, bar);
            __builtin_amdgcn_fence(__ATOMIC_ACQUIRE, "agent");
            asm volatile("s_waitcnt vmcnt(0)" ::: "memory");
        }
    }
    __syncthreads();
}

DI void xcd_ids(const XcdBarrier& b) {
    if (threadIdx.x == 0) {
        const unsigned rank = b.st[2], x = b.st[3]; unsigned blocked = rank, inter = 0u;
#pragma unroll
        for (unsigned j = 0; j < 16; ++j) { const unsigned c = xb_ld(&b.bar[XB_XCNT(j)]); if (j < x) blocked += c; inter += (c < rank ? c : rank) + ((j < x && c > rank) ? 1u : 0u); }
        b.st[4] = blocked; b.st[5] = inter;
    }
    __syncthreads();
}
#ifndef PROBE_ATT
#define PROBE_ATT 0
#endif
#ifndef PROBE_SCAN
#define PROBE_SCAN 0
#endif
#ifndef PROBE_GEMM
#define PROBE_GEMM 0
#endif
#define GREP for (int rep_ = 0; rep_ < (PROBE_GEMM ? 2 : 1); ++rep_)
#ifndef PROBE_SYNC
#define PROBE_SYNC 0
#endif
#define GSYNC() do { xcd_barrier(xbar); if (PROBE_SYNC) xcd_barrier(xbar); } while (0)
#ifndef PH_MASK
#define PH_MASK 0xFFFFF
#endif
#define PH(b) if ((PH_MASK >> (b)) & 1)
#define WSP (KWS())
#define SLP (KWS() + WS_SL)
#define MODP ((const float*)(KWS() + TAB_MOD))
#define ROPEP ((const float*)(KWS() + TAB_ROPE))
#define LBTP ((const float*)(KWS() + TAB_LB))
#define LAMTP ((const float*)(KWS() + TAB_LAM))
#define XCP ((float*)(KWS() + WS_XC))
#define MODL (MODP + (size_t)l * 9 * 6144)
#define UP_ ((bf16_t*)(SLP + 1 * SLAB))
#define ACTP ((bf16_t*)(SLP + SLAB * 15 / 4))
__global__ void __launch_bounds__(NTHR, 2) fwd_megakernel(Ptrs P) {
    extern __shared__ __attribute__((aligned(16))) unsigned char lds_raw[];
    LAS unsigned char* lds = (LAS unsigned char*)lds_raw;
    cg::grid_group grid = cg::this_grid();
    const int G = gridDim.x, NGW = G * NWAVES, ngt = G * NTHR;
    const size_t TS = (size_t)256 * D * 2;

    unsigned* barw = (unsigned*)(WSP + WS_BAR);
    if (gridDim.x == 0x7fffffffu) grid.sync();
    if (threadIdx.x < 16) ((volatile LAS unsigned*)(lds + LDS_BYTES - 64))[threadIdx.x] = 0u;
    __syncthreads();
    const XcdBarrier xbar = xcd_barrier_post(barw, (volatile LAS unsigned*)(lds + LDS_BYTES - 64));
    PH(0) p0_tables(lds);
    __syncthreads();
    PH(1) convert_weights(0, lds, NGW);
    GSYNC();
    xcd_ids(xbar);
    PH(2) { RW a{}; a.xin_lat = KP(x); a.xin_ctx = KP(ctx); a.Y = nullptr; a.g_pre = KP(g_pre_mix); a.modB = MODP; a.sh_chunk = 0; a.H = (bf16_t*)SLP; a.skipctx = 0; rw_phase(a, NGW); }
    GSYNC();

    for (int l = 0; l < 2; ++l) {
        const bool last = (l == 1); const int skc = last ? 1 : 0;
        const bool hg_split = (G >= 256);
        PH(3) GREP { SchedHG S; S.o.init(136, hg_split ? 16 : 20, G, WG_INTER()); S.A = (const char*)SLP; S.B = (const char*)(WSP + WS_WIN); S.tstep = TS; S.extra = (hg_split && !last) ? 32 : 0; S.qextra = hg_split ? PMQ * 4 : 0;
          EpiIn E{SLP, 0, LBTP + l * 2048, ROPEP}; pg8::gemm_phase(lds, D, S, E); }
        GSYNC();
        if (PROBE_SCAN) { scan_phase(SLP, l, !last, WSP == nullptr, lds); }
        PH(4) scan_phase(SLP, l, !last, true, lds);
        if (hg_split && blockIdx.x >= 128) {
            SchedG S; S.o.init(128, 4, G - 128, (int)blockIdx.x - 128); S.A = (const char*)SLP; S.B = (const char*)(WSP + WS_WIN) + (size_t)4096 * D * 2; S.tstep = TS; S.skipctx = 1;
            EpiIn E{SLP, 3, nullptr, nullptr}; pg8::gemm_phase(lds, D, S, E); }
        GSYNC();
        PH(5) combine_phase(SLP, KP(hg_norm_g) + l * 128, last, NGW);
        GSYNC();
        PH(6) GREP { SchedATQ S; S.o.init(136, 8, G, WG_INTER()); S.A = (const char*)SLP; S.B = (const char*)(WSP + WS_WIN) + (size_t)5120 * D * 2; S.tstep = TS; S.qfirst = hg_split ? PMQ : 0;
          EpiIn E{SLP, 1, nullptr, ROPEP}; pg8::gemm_phase(lds, D, S, E); }
        GSYNC();
        if (PROBE_ATT) { attn_phase(SLP, (bf16_t*)(SLP + 5 * SLAB), l, !last, LAMTP, KP(att_subln_g) + l * 128, lds, hg_split); }
        PH(7) attn_phase(SLP, (bf16_t*)(SLP + 2 * SLAB), l, !last, LAMTP, KP(att_subln_g) + l * 128, lds, hg_split);
        GSYNC();
        PH(8) GREP { SchedG S; S.o.init(last ? 128 : 136, 8, G, WG_INTER()); S.A = (const char*)SLP; S.B = (const char*)(WSP + WS_WIN) + (size_t)8192 * D * 2; S.tstep = TS; S.skipctx = skc;
          EpiIn E{SLP, 2, nullptr, ROPEP}; pg8::gemm_phase(lds, D, S, E); }
        GSYNC();
        PH(9) gmlp_phase(SLP, KP(gm_ln_g) + l * 1024, KP(gm_ln_b) + l * 1024, KP(gm_ws) + (size_t)l * 8 * 128 * 128, KP(gm_bs) + l * 1024, last, lds);
        GSYNC();
        PH(10) GREP { SchedM S; S.o.init(last ? 128 : 136, 4, G, WG_INTER()); S.ws = (const char*)WSP; S.skipctx = skc;
          EpiMerge E{SLP + 5 * SLAB + (size_t)blockIdx.x * (48 * 512 * 16), (bf16_t*)(SLP + 4 * SLAB)}; pg8::gemm_phase(lds, D, S, E); }
        GSYNC();
        PH(11) GREP { SchedG S; S.o.init(last ? 128 : 136, 4, G, WG_INTER()); S.A = (const char*)(SLP + 4 * SLAB); S.B = (const char*)(WSP + WS_WOUT); S.tstep = TS; S.skipctx = skc;
          EpiB16 E{(bf16_t*)(SLP + 2 * SLAB), D}; pg8::gemm_phase(lds, D, S, E); }
        GSYNC();
        PH(12) { RW a{}; a.xin_lat = (l == 0) ? KP(x) : KOUT(); a.xin_ctx = (l == 0) ? KP(ctx) : XCP; a.xo_lat = KOUT(); a.xo_ctx = XCP; a.Y = (const bf16_t*)(SLP + 2 * SLAB); a.g_post = KP(g_post_mix) + l * D; a.modA = MODL; a.gate_chunk = 2;
          a.g_pre = KP(g_pre_ffn) + l * D; a.modB = MODL; a.sh_chunk = 3; a.H = (bf16_t*)SLP; a.skipctx = skc; rw_phase(a, NGW); }
        GSYNC();
        for (int hf = 0; hf < 2; ++hf) {
            PH(13) GREP { SchedG S; S.o.init(last ? 128 : 136, 11, G, WG_INTER()); S.A = (const char*)SLP; S.B = (const char*)(WSP + WS_WUP) + (size_t)hf * DFF * D * 2; S.tstep = TS; S.skipctx = skc;
              EpiB16 E{UP_, DFF}; pg8::gemm_phase(lds, D, S, E); }
            GSYNC();
            PH(14) act_phase(UP_, ACTP, KP(conv_w) + (size_t)l * 3 * 2 * DFF, KP(conv_b) + (size_t)l * 2 * DFF, hf, last, ngt);
            GSYNC();
        }
        PH(15) GREP { SchedG S; S.o.init(last ? 128 : 136, 4, G, WG_INTER()); S.A = (const char*)ACTP; S.B = (const char*)(WSP + WS_WDN); S.tstep = (size_t)256 * DFF * 2; S.skipctx = skc;
          EpiB16 E{(bf16_t*)(SLP + 1 * SLAB), D}; pg8::gemm_phase(lds, DFF, S, E); }
        GSYNC();
        PH(16) { RW a{}; a.xin_lat = KOUT(); a.xin_ctx = XCP; a.xo_lat = KOUT(); a.xo_ctx = XCP; a.Y = (const bf16_t*)(SLP + 1 * SLAB); a.g_post = KP(g_post_ffn) + l * D; a.modA = MODL; a.gate_chunk = 5;
          if (!last) { a.g_pre = KP(g_pre_mix) + (l + 1) * D; a.modB = MODP + (size_t)(l + 1) * 9 * 6144; a.sh_chunk = 0; a.H = (bf16_t*)SLP; }
          a.skipctx = skc; rw_phase(a, NGW); }
        PH(17) if (!last) { convert_weights(l + 1, lds, NGW); GSYNC(); }
    }
}

extern "C" void kernel_launch(void* const* d_in, const int* in_sizes, int n_in, void* d_out, int out_size, void* d_ws, size_t ws_size, hipStream_t stream) {
    static int grid = 0;
    if (grid == 0) {
        if (n_in != 30 || ws_size < WS_END) { fprintf(stderr, "kernel_launch: need 30 inputs and >= %zu bytes of workspace (got %d, %zu)\n", (size_t)WS_END, n_in, ws_size); grid = -1; return; }
        int dev = 0, cus = 0, per_cu = 0;
        hipGetDevice(&dev); hipDeviceGetAttribute(&cus, hipDeviceAttributeMultiprocessorCount, dev);
        hipFuncSetAttribute((const void*)fwd_megakernel, hipFuncAttributeMaxDynamicSharedMemorySize, LDS_BYTES);
        hipOccupancyMaxActiveBlocksPerMultiprocessor(&per_cu, (const void*)fwd_megakernel, NTHR, LDS_BYTES);
        (void)hipGetLastError();
        if (per_cu < 1) per_cu = 1;
        grid = cus * 1;
    }
    if (grid < 0) return;
    Ptrs p{};
    const float** pp = (const float**)&p;
    for (int i = 0; i < 30; ++i) pp[i] = (const float*)d_in[i];
    p.out = (float*)d_out; p.ws = (unsigned char*)d_ws;
    void* args[] = {&p};
    if (hipMemsetAsync((char*)d_ws + WS_BAR, 0, XCD_BAR_WORDS * 4, stream) != hipSuccess) { fprintf(stderr, "kernel_launch: hipMemsetAsync of the barrier words failed\n"); return; }
    hipError_t e = hipLaunchCooperativeKernel((const void*)fwd_megakernel, dim3(grid), dim3(NTHR), args, LDS_BYTES, stream);
    if (e != hipSuccess) fprintf(stderr, "cooperative launch failed: %s (grid %d)\n", hipGetErrorString(e), grid);
}
```

```cpp
#include <hip/hip_runtime.h>
#include <hip/hip_cooperative_groups.h>
#include <cstdio>
#include <cstdint>
namespace cg = cooperative_groups;

#define DI __device__ __forceinline__
#define LAS __attribute__((address_space(3)))
typedef unsigned short bf16_t;
typedef short bf16x8 __attribute__((ext_vector_type(8)));
typedef short s16x4 __attribute__((ext_vector_type(4)));
typedef float f32x4 __attribute__((ext_vector_type(4)));
typedef float f32x16 __attribute__((ext_vector_type(16)));
typedef unsigned u32x4 __attribute__((ext_vector_type(4)));
typedef unsigned u32x2 __attribute__((ext_vector_type(2)));
typedef float f32x2_t __attribute__((ext_vector_type(2)));
typedef __bf16 bf16x2_t __attribute__((ext_vector_type(2)));
DI unsigned cvtpk(float lo, float hi) { f32x2_t v = {lo, hi}; bf16x2_t b = __builtin_convertvector(v, bf16x2_t); return __builtin_bit_cast(unsigned, b); }
DI float bf2f(unsigned short u) { return __uint_as_float(((unsigned)u) << 16); }
DI float bflo(unsigned w) { return __uint_as_float(w << 16); }
DI float bfhi(unsigned w) { return __uint_as_float(w & 0xffff0000u); }
DI unsigned short f2bf(float f) { return (unsigned short)(cvtpk(f, 0.f) & 0xffffu); }
#define MFMA32(a, b, c) __builtin_amdgcn_mfma_f32_32x32x16_bf16((a), (b), (c), 0, 0, 0)
DI int opaque_tid() { int t = threadIdx.x; asm volatile("" : "+v"(t)); return t; }
DI int crow(int reg, int h) { return (reg & 3) + 8 * (reg >> 2) + 4 * h; }

constexpr int D = 1024, NB = 8, TL = 4096, LC = 256, TP = TL + LC, M = NB * TP;
constexpr int DFF = 2816, DFFH = 1408;
constexpr float EPS = 1e-6f;
constexpr float QSCALE = 0.125f * 1.4426950408889634f;
constexpr size_t MiB = (size_t)1 << 20;
constexpr size_t SLAB = (size_t)M * D * 2;
constexpr size_t TAB_MOD = 0;
constexpr size_t TAB_ROPE = 448 * 1024;
constexpr size_t TAB_LB = 460 * 1024;
constexpr size_t TAB_LAM = 480 * 1024;
constexpr size_t WS_BAR = 1024 * 1024;
constexpr size_t WS_WIN = 2 * MiB, WS_WBR = 28 * MiB, WS_WOUT = 34 * MiB, WS_WUP = 36 * MiB, WS_WDN = 47 * MiB;
constexpr size_t WS_XC = 53 * MiB, WS_SL = 62 * MiB, WS_END = WS_SL + SLAB * 13 / 2;
constexpr int NWAVES = 8, NTHR = 512;
constexpr int PMQ = 24;
constexpr int LDS_BYTES = 147456;
#define WG_BLOCKED() ((int)__builtin_amdgcn_readfirstlane((int)((volatile LAS unsigned*)(lds + LDS_BYTES - 64))[4]))
#define WG_INTER()   ((int)__builtin_amdgcn_readfirstlane((int)((volatile LAS unsigned*)(lds + LDS_BYTES - 64))[5]))

namespace pg8 {
constexpr int BM = 256, BK = 64, HALF = 128, HTB = HALF * BK * 2, STAGE_BYTES = 8 * HTB, NXCD = 8, WGM = 8;
DI int lds_byte(int r, int c) { const int st = (r >> 4) * 2 + (c >> 5), rr = r & 15, cc = c & 31, ob = rr * 64 + cc * 2; return st * 1024 + (ob ^ (((ob >> 9) & 1) << 5)); }
DI void stage_rc(int b, int& R, int& C) { const int st = b / 1024, sb = b % 1024, swz = sb ^ (((sb >> 9) & 1) << 5); R = (st >> 1) * 16 + swz / 64; C = (st & 1) * 32 + (swz % 64) / 2; }
DI int perm32(int rho) { const int n = rho >> 4, i = rho & 15; return 8 * (i >> 2) + 4 * n + (i & 3); }
struct Unit { int pm, pn, sub; const char* a; const char* b; };
struct TileOrder {
    int nM, nN, nwg, G, c;
    DI void init(int nM_, int nN_, int G_, int c_) { nM = nM_; nN = nN_; nwg = nM * nN; G = G_; c = c_; }
    DI bool get(long L, int& pm, int& pn) const {
        if (L >= nwg) return false;
        int wgid = (int)L; { const int q = nwg / NXCD, r = nwg % NXCD, xcd = wgid % NXCD, off = wgid / NXCD; wgid = (xcd < r ? xcd * (q + 1) : r * (q + 1) + (xcd - r) * q) + off; }
        const int nig = WGM * nN, gid = wgid / nig, fm = gid * WGM, gsz = (nM - fm) < WGM ? (nM - fm) : WGM;
        pm = fm + ((wgid % nig) % gsz); pn = (wgid % nig) / gsz; return true;
    }
};
template <class Epi, class Sched>
DI void gemm_phase(LAS unsigned char* lds, const int K, const Sched& S, const Epi& E) {
    const int tid = opaque_tid(), wid = __builtin_amdgcn_readfirstlane(tid >> 6), lane = tid & 63, wr = wid >> 2, wc = wid & 3, fr = lane & 15, fq = lane >> 4;
    const int nt = K / BK;
    unsigned voffA[2], voffB[2];
#pragma unroll
    for (int i = 0; i < 2; ++i) { int R, C; stage_rc(tid * 16 + i * 8192, R, C); const int Rb = (R & ~31) + perm32(R & 31);
        voffA[i] = (unsigned)(R * K + C) * 2u; voffB[i] = (unsigned)(Rb * K + C) * 2u; }
    const size_t kstep = (size_t)(BK * 2);
    const size_t hstep = (size_t)HALF * K * 2;
    const unsigned ldsw = (unsigned)wid * 1024u;
    const int aoff = lds_byte(wr * 64 + fr, fq * 8), boff = lds_byte(wc * 32 + fr, fq * 8);
#define PG8_SA(b, h) (((b) * 2 + (h)) * HTB)
#define PG8_SB(b, h) ((4 + (b) * 2 + (h)) * HTB)
#define PG8_STAGE(bufoff, gbase, voff) do { _Pragma("unroll") for (int _i = 0; _i < 2; ++_i) \
        __builtin_amdgcn_global_load_lds((const unsigned*)((const char*)(gbase) + (voff)[_i]), (LAS unsigned*)(lds + (bufoff) + ldsw + _i * 8192), 16, 0, 0); } while (0)
#define PG8_LDA(dst, b, h) do { _Pragma("unroll") for (int m = 0; m < 4; ++m) _Pragma("unroll") for (int k = 0; k < 2; ++k) dst[m][k] = *(const LAS bf16x8*)(lds + PG8_SA(b, h) + aoff + m * 2048 + k * 1024); } while (0)
#define PG8_LDB(dst, b, h) do { _Pragma("unroll") for (int n = 0; n < 2; ++n) _Pragma("unroll") for (int k = 0; k < 2; ++k) dst[n][k] = *(const LAS bf16x8*)(lds + PG8_SB(b, h) + boff + n * 2048 + k * 1024); } while (0)
#define PG8_MMA(ai, bj, At, Bt) do { __builtin_amdgcn_s_setprio(1); _Pragma("unroll") for (int m = 0; m < 4; ++m) _Pragma("unroll") for (int n = 0; n < 2; ++n) _Pragma("unroll") for (int k = 0; k < 2; ++k) \
        acc[ai][bj][m][n] = __builtin_amdgcn_mfma_f32_16x16x32_bf16(Bt[n][k], At[m][k], acc[ai][bj][m][n], 0, 0, 0); __builtin_amdgcn_s_setprio(0); } while (0)
#define PG8_WAIT_V(n) asm volatile("s_waitcnt vmcnt(" #n ")" ::: "memory")
#define PG8_WAIT_L(n) asm volatile("s_waitcnt lgkmcnt(" #n ")" ::: "memory")
#define PG8_BAR __builtin_amdgcn_s_barrier()
#define PG8_SCHED __builtin_amdgcn_sched_barrier(0)
    Unit cur, nxt; int ui = 0;
    if (!S.next(0, cur)) return;
    f32x4 acc[2][2][4][2];
#pragma unroll
    for (int a = 0; a < 2; ++a)
#pragma unroll
        for (int b = 0; b < 2; ++b)
#pragma unroll
            for (int m = 0; m < 4; ++m)
#pragma unroll
                for (int n = 0; n < 2; ++n) acc[a][b][m][n] = (f32x4){0.f, 0.f, 0.f, 0.f};
    bf16x8 At[4][2], B0[2][2], B1[2][2];
    const char* cA = cur.a; const char* cB = cur.b;
    PG8_STAGE(PG8_SB(0, 0), cB, voffB); PG8_STAGE(PG8_SB(0, 1), cB + hstep, voffB); PG8_STAGE(PG8_SA(0, 0), cA, voffA); PG8_STAGE(PG8_SA(0, 1), cA + hstep, voffA);
    if (wr == 1) PG8_BAR;
    PG8_WAIT_V(2); PG8_BAR;
    PG8_STAGE(PG8_SB(1, 0), cB + kstep, voffB); PG8_STAGE(PG8_SA(1, 0), cA + kstep, voffA); PG8_STAGE(PG8_SB(1, 1), cB + hstep + kstep, voffB);
    PG8_WAIT_V(6); PG8_BAR;
    for (;;) {
        const bool has_next = S.next(ui + 1, nxt);
        const char* nA = has_next ? nxt.a : cA; const char* nB = has_next ? nxt.b : cB;
        for (int t = 0; t < nt; t += 2) {
            const bool last = (t == nt - 2);
            const char* a1 = cA + (size_t)(t + 1) * kstep;
            const char* a2 = last ? nA : cA + (size_t)(t + 2) * kstep; const char* b2 = last ? nB : cB + (size_t)(t + 2) * kstep;
            const char* a3 = a2 + kstep; const char* b3 = b2 + kstep;
            PG8_LDB(B0, 0, 0); PG8_LDB(B1, 0, 1); PG8_SCHED; PG8_LDA(At, 0, 0); PG8_STAGE(PG8_SA(1, 1), a1 + hstep, voffA);
            PG8_WAIT_V(8); PG8_WAIT_L(0); PG8_BAR; PG8_MMA(0, 0, At, B0); PG8_MMA(0, 1, At, B1); PG8_BAR; PG8_SCHED;
            PG8_LDA(At, 0, 1); PG8_STAGE(PG8_SB(0, 0), b2, voffB); PG8_STAGE(PG8_SB(0, 1), b2 + hstep, voffB); PG8_STAGE(PG8_SA(0, 0), a2, voffA);
            PG8_WAIT_V(8); PG8_WAIT_L(0); PG8_BAR; PG8_MMA(1, 0, At, B0); PG8_MMA(1, 1, At, B1); PG8_BAR; PG8_SCHED;
            PG8_LDB(B0, 1, 0); PG8_LDB(B1, 1, 1); PG8_SCHED; PG8_LDA(At, 1, 0); PG8_STAGE(PG8_SA(0, 1), a2 + hstep, voffA);
            PG8_WAIT_V(8); PG8_WAIT_L(0); PG8_BAR; PG8_MMA(0, 0, At, B0); PG8_MMA(0, 1, At, B1); PG8_BAR; PG8_SCHED;
            PG8_LDA(At, 1, 1); PG8_STAGE(PG8_SB(1, 0), b3, voffB); PG8_STAGE(PG8_SB(1, 1), b3 + hstep, voffB); PG8_STAGE(PG8_SA(1, 0), a3, voffA);
            PG8_WAIT_V(8); PG8_WAIT_L(0); PG8_BAR; PG8_MMA(1, 0, At, B0); PG8_MMA(1, 1, At, B1); PG8_BAR; PG8_SCHED;
        }
        if (wr == 0) PG8_BAR;
        { int efr = fr, efq = fq; asm volatile("" : "+v"(efr), "+v"(efq)); E(acc, cur, wr, wc, efr, efq); }
        if (!has_next) break;
#pragma unroll
        for (int a = 0; a < 2; ++a)
#pragma unroll
            for (int b = 0; b < 2; ++b)
#pragma unroll
                for (int m = 0; m < 4; ++m)
#pragma unroll
                    for (int n = 0; n < 2; ++n) acc[a][b][m][n] = (f32x4){0.f, 0.f, 0.f, 0.f};
        cur = nxt; cA = nA; cB = nB; ++ui;
        if (wr == 1) PG8_BAR;
    }
    PG8_WAIT_V(0);
    PG8_BAR;
#undef PG8_SA
#undef PG8_SB
#undef PG8_STAGE
#undef PG8_LDA
#undef PG8_LDB
#undef PG8_MMA
#undef PG8_WAIT_V
#undef PG8_WAIT_L
#undef PG8_BAR
#undef PG8_SCHED
}
}
typedef f32x4 AccT[2][2][4][2];

struct SchedG {
    pg8::TileOrder o; const char* A; const char* B; size_t tstep; int skipctx;
    DI bool next(int i, pg8::Unit& u) const {
        int pm, pn; if (!o.get((long)i * o.G + o.c, pm, pn)) return false;
        if (skipctx) pm += pm >> 4;
        u.pm = pm; u.pn = pn; u.sub = 0; u.a = A + (size_t)pm * tstep; u.b = B + (size_t)pn * tstep; return true;
    }
};
struct SchedHG {
    pg8::TileOrder o; const char* A; const char* B; size_t tstep; int extra, qextra;
    DI bool next(int i, pg8::Unit& u) const {
        const long L = (long)i * o.G + o.c; int pm, pn, pb;
        if (L < o.nwg) { o.get(L, pm, pn); pb = pn; }
        else if (L < o.nwg + extra) { const int j = (int)(L - o.nwg); pm = 17 * (j >> 2) + 16; pn = 16 + (j & 3); pb = pn; }
        else if (L < o.nwg + extra + qextra) { const int j = (int)(L - o.nwg - extra); pm = j >> 2; pn = 100 + (j & 3); pb = 20 + (j & 3); }
        else return false;
        u.pm = pm; u.pn = pn; u.sub = 0; u.a = A + (size_t)pm * tstep; u.b = B + (size_t)pb * tstep; return true;
    }
};
struct SchedATQ {
    pg8::TileOrder o; const char* A; const char* B; size_t tstep; int qfirst;
    DI bool next(int i, pg8::Unit& u) const {
        const long L = (long)i * o.G + o.c; int pm, pn;
        if (L < o.nwg) { o.get(L, pm, pn); pn += 4; }
        else { const int j = (int)(L - o.nwg); pm = qfirst + (j >> 2); pn = j & 3; if (pm >= 136) return false; }
        u.pm = pm; u.pn = pn; u.sub = 0; u.a = A + (size_t)pm * tstep; u.b = B + (size_t)pn * tstep; return true;
    }
};
struct SchedM {
    pg8::TileOrder o; const char* ws; int skipctx;
    DI bool next(int i, pg8::Unit& u) const {
        const int ti = i / 6, sub = i - ti * 6;
        int pm, pn; if (!o.get((long)ti * o.G + o.c, pm, pn)) return false;
        if (skipctx) pm += pm >> 4;
        const int j = sub >> 1; const size_t tstep = (size_t)256 * D * 2;
        u.pm = pm; u.pn = pn; u.sub = sub;
        if (sub & 1) { const size_t yo = (j == 0) ? 2 * SLAB : (j == 1 ? 3 * SLAB : 1 * SLAB); u.a = ws + WS_SL + yo + (size_t)pm * tstep; u.b = ws + WS_WBR + (size_t)j * (2 * MiB) + (size_t)pn * tstep; }
        else { u.a = ws + WS_SL + (size_t)pm * tstep; u.b = ws + WS_WIN + (size_t)10240 * D * 2 + (size_t)j * (2 * MiB) + (size_t)pn * tstep; }
        return true;
    }
};

DI float silu_f(float v) { return v * __builtin_amdgcn_rcpf(1.f + __builtin_amdgcn_exp2f(-1.4426950408889634f * v)); }
DI float gelu_f(float v) { const float z = (-1.5957691216f * 1.4426950408889634f) * (v + 0.044715f * v * v * v); return v * __builtin_amdgcn_rcpf(1.f + __builtin_amdgcn_exp2f(z)); }
DI float sigm_f(float v) { return __builtin_amdgcn_rcpf(1.f + __builtin_amdgcn_exp2f(-1.4426950408889634f * v)); }
DI float logf_gate(float z, float lbv) {
    const float sg = __builtin_amdgcn_rcpf(1.f + __builtin_amdgcn_exp2f(-1.4426950408889634f * z));
    const float f = fmaxf(lbv + (1.f - lbv) * sg, 1e-30f);
    return 0.6931471805599453f * __builtin_amdgcn_logf(f);
}
template <int TYPE>
DI void epi_apply(const AccT& acc, const pg8::Unit& u, int ct, int wr, int wc, int fr, int fq, bf16_t* dst, const float* lbp, const float* rope, float* rstat = nullptr) {
    const int row0 = u.pm * 256 + wr * 64 + fr; const int c0 = ct * 256 + wc * 32 + 8 * fq;
    const bool isctx = ((u.pm % 17) == 16);
    f32x4 lbq[2][2];
    if (TYPE == 3) {
#pragma unroll
        for (int bj = 0; bj < 2; ++bj) { lbq[bj][0] = *(const f32x4*)(lbp + c0 + bj * 128); lbq[bj][1] = *(const f32x4*)(lbp + c0 + bj * 128 + 4); }
    }
#pragma unroll
    for (int ai = 0; ai < 2; ++ai) {
      f32x4 csq[4], snq[4];
      if (TYPE == 4 || TYPE == 5) {
#pragma unroll
          for (int q = 0; q < 4; ++q) { csq[q] = (f32x4){1.f, 1.f, 1.f, 1.f}; snq[q] = (f32x4){0.f, 0.f, 0.f, 0.f}; }
          if (!isctx) {
#pragma unroll
              for (int q = 0; q < 4; ++q) { const int row = row0 + ai * 128 + q * 16; const int p = row - (u.pm / 17) * TP; const int pos = (wc & 1) ? (p & 63) : (p >> 6);
                  csq[q] = *(const f32x4*)(rope + pos * 16 + 4 * fq); snq[q] = *(const f32x4*)(rope + 1024 + pos * 16 + 4 * fq); }
          }
      }
#pragma unroll
        for (int m = 0; m < 4; ++m) {
            const int row = row0 + ai * 128 + m * 16;
            bf16_t* rowp = dst + (size_t)row * D + c0;
            float rs_ = 0.f, rq_ = 0.f;
            f32x4 cs = {1.f, 1.f, 1.f, 1.f}, sn = {0.f, 0.f, 0.f, 0.f};
            if (TYPE == 4 || TYPE == 5) { cs = csq[m]; sn = snq[m]; }
#pragma unroll
            for (int bj = 0; bj < 2; ++bj) {
                f32x4 v0 = acc[ai][bj][m][0], v1 = acc[ai][bj][m][1];
                if (TYPE == 1) {
#pragma unroll
                    for (int i = 0; i < 4; ++i) { v0[i] = silu_f(v0[i]); v1[i] = silu_f(v1[i]); }
                } else if (TYPE == 2 || TYPE == 6) {
#pragma unroll
                    for (int i = 0; i < 4; ++i) { v0[i] = gelu_f(v0[i]); v1[i] = gelu_f(v1[i]); }
                    if (TYPE == 6) {
#pragma unroll
                        for (int i = 0; i < 4; ++i) { rs_ += v0[i] + v1[i]; rq_ += v0[i] * v0[i] + v1[i] * v1[i]; }
                    }
                } else if (TYPE == 3) {
                    const f32x4 lb0 = lbq[bj][0], lb1 = lbq[bj][1];
#pragma unroll
                    for (int i = 0; i < 4; ++i) { v0[i] = logf_gate(v0[i], lb0[i]); v1[i] = logf_gate(v1[i], lb1[i]); }
                } else if (TYPE == 4 || TYPE == 5) {
                    const f32x4 o0 = v0 * cs - v1 * sn, o1 = v1 * cs + v0 * sn;
                    v0 = o0; v1 = o1;
                    if (TYPE == 4) { v0 = v0 * QSCALE; v1 = v1 * QSCALE; }
                }
                u32x4 w; w.x = cvtpk(v0[0], v0[1]); w.y = cvtpk(v0[2], v0[3]); w.z = cvtpk(v1[0], v1[1]); w.w = cvtpk(v1[2], v1[3]);
                *(u32x4*)(rowp + bj * 128) = w;
                __builtin_amdgcn_sched_barrier(0);
            }
            if (TYPE == 6) {
                rs_ += __shfl_xor(rs_, 16); rs_ += __shfl_xor(rs_, 32); rq_ += __shfl_xor(rq_, 16); rq_ += __shfl_xor(rq_, 32);
                if (fq == 0) { f32x2_t* sp_ = (f32x2_t*)(rstat + ((size_t)row * 16 + ct * 4 + wc) * 2); *sp_ = (f32x2_t){rs_, rq_}; }
            }
        }
    }
}
struct EpiIn {
    unsigned char* sl; int stage; const float* lb; const float* rope;
    DI void operator()(const AccT& acc, const pg8::Unit& u, int wr, int wc, int fr, int fq) const {
        const int blk = u.pn >> 2, ct = u.pn & 3;
        if (stage == 3) { epi_apply<1>(acc, u, ct, wr, wc, fr, fq, (bf16_t*)(sl + 5 * SLAB), nullptr, nullptr); return; }
        if (stage == 0) {
            if (u.pn >= 100) { epi_apply<4>(acc, u, u.pn - 100, wr, wc, fr, fq, (bf16_t*)(sl + 6 * SLAB), nullptr, rope); return; }
            if (blk == 0) epi_apply<1>(acc, u, ct, wr, wc, fr, fq, (bf16_t*)(sl + 1 * SLAB), nullptr, nullptr);
            else if (blk == 1) epi_apply<3>(acc, u, ct, wr, wc, fr, fq, (bf16_t*)(sl + 2 * SLAB), lb, nullptr);
            else if (blk == 2) epi_apply<3>(acc, u, ct, wr, wc, fr, fq, (bf16_t*)(sl + 3 * SLAB), lb + 1024, nullptr);
            else if (blk == 3) epi_apply<0>(acc, u, ct, wr, wc, fr, fq, (bf16_t*)(sl + 4 * SLAB), nullptr, nullptr);
            else epi_apply<1>(acc, u, ct, wr, wc, fr, fq, (bf16_t*)(sl + 5 * SLAB), nullptr, nullptr);
        } else if (stage == 1) {
            if (blk == 0) epi_apply<4>(acc, u, ct, wr, wc, fr, fq, (bf16_t*)(sl + 2 * SLAB), nullptr, rope);
            else if (blk == 1) epi_apply<5>(acc, u, ct, wr, wc, fr, fq, (bf16_t*)(sl + 3 * SLAB), nullptr, rope);
            else epi_apply<0>(acc, u, ct, wr, wc, fr, fq, (bf16_t*)(sl + 4 * SLAB), nullptr, nullptr);
        } else {
            if (blk == 0) epi_apply<2>(acc, u, ct, wr, wc, fr, fq, (bf16_t*)(sl + 3 * SLAB), nullptr, nullptr);
            else epi_apply<6>(acc, u, ct, wr, wc, fr, fq, (bf16_t*)(sl + 4 * SLAB), nullptr, nullptr, (float*)(sl + 5 * SLAB));
        }
    }
};
struct EpiF32 {
    float* Y; int ldc;
    DI void operator()(const AccT& acc, const pg8::Unit& u, int wr, int wc, int fr, int fq) const {
        const int row0 = u.pm * 256 + wr * 64 + fr; const int c0 = u.pn * 256 + wc * 32 + 8 * fq;
#pragma unroll
        for (int ai = 0; ai < 2; ++ai)
#pragma unroll
            for (int m = 0; m < 4; ++m) { float* rowp = Y + (size_t)(row0 + ai * 128 + m * 16) * ldc + c0;
#pragma unroll
                for (int bj = 0; bj < 2; ++bj) { *(f32x4*)(rowp + bj * 128) = acc[ai][bj][m][0]; *(f32x4*)(rowp + bj * 128 + 4) = acc[ai][bj][m][1]; } }
    }
};
struct EpiB16 {
    bf16_t* O; int ldc;
    DI void operator()(const AccT& acc, const pg8::Unit& u, int wr, int wc, int fr, int fq) const {
        const int row0 = u.pm * 256 + wr * 64 + fr; const int c0 = u.pn * 256 + wc * 32 + 8 * fq;
#pragma unroll
        for (int ai = 0; ai < 2; ++ai)
#pragma unroll
            for (int m = 0; m < 4; ++m) { bf16_t* rowp = O + (size_t)(row0 + ai * 128 + m * 16) * ldc + c0;
#pragma unroll
                for (int bj = 0; bj < 2; ++bj) { const f32x4 v0 = acc[ai][bj][m][0], v1 = acc[ai][bj][m][1];
                    u32x4 w; w.x = cvtpk(v0[0], v0[1]); w.y = cvtpk(v0[2], v0[3]); w.z = cvtpk(v1[0], v1[1]); w.w = cvtpk(v1[2], v1[3]);
                    *(u32x4*)(rowp + bj * 128) = w; } }
    }
};
struct EpiMerge {
    unsigned char* scr;
    bf16_t* Ys;
    DI void operator()(const AccT& acc, const pg8::Unit& u, int wr, int wc, int fr, int fq) const {
        const int tid = opaque_tid();
        unsigned char* gsc = scr; unsigned char* ysc = scr + 16 * 512 * 16; unsigned to = (unsigned)tid * 16u; asm volatile("" : "+v"(to));
        const int sub = u.sub;
        if ((sub & 1) == 0) {
#pragma unroll
            for (int ai = 0; ai < 2; ++ai)
#pragma unroll
                for (int bj = 0; bj < 2; ++bj)
#pragma unroll
                    for (int m = 0; m < 4; ++m) { const f32x4 v0 = acc[ai][bj][m][0], v1 = acc[ai][bj][m][1];
                        u32x4 w; w.x = cvtpk(sigm_f(v0[0]), sigm_f(v0[1])); w.y = cvtpk(sigm_f(v0[2]), sigm_f(v0[3])); w.z = cvtpk(sigm_f(v1[0]), sigm_f(v1[1])); w.w = cvtpk(sigm_f(v1[2]), sigm_f(v1[3]));
                        *(u32x4*)(gsc + ((ai * 2 + bj) * 4 + m) * 8192 + to) = w; __builtin_amdgcn_sched_barrier(0); }
        } else {
            const int row0 = u.pm * 256 + wr * 64 + fr; const int c0 = u.pn * 256 + wc * 32 + 8 * fq;
#pragma unroll
            for (int ai = 0; ai < 2; ++ai)
#pragma unroll
                for (int bj = 0; bj < 2; ++bj) {
                    u32x4 g[4], ys[4];
#pragma unroll
                    for (int m = 0; m < 4; ++m) { const int e = (ai * 2 + bj) * 4 + m; g[m] = *(const u32x4*)(gsc + e * 8192 + to);
                        ys[m] = (sub > 1) ? *(const u32x4*)(ysc + e * 8192 + to) : (u32x4){0u, 0u, 0u, 0u}; }
#pragma unroll
                    for (int m = 0; m < 4; ++m) { const int e = (ai * 2 + bj) * 4 + m;
                        f32x4 y0 = acc[ai][bj][m][0], y1 = acc[ai][bj][m][1];
                        y0[0] = y0[0] * bflo(g[m].x) + bflo(ys[m].x); y0[1] = y0[1] * bfhi(g[m].x) + bfhi(ys[m].x); y0[2] = y0[2] * bflo(g[m].y) + bflo(ys[m].y); y0[3] = y0[3] * bfhi(g[m].y) + bfhi(ys[m].y);
                        y1[0] = y1[0] * bflo(g[m].z) + bflo(ys[m].z); y1[1] = y1[1] * bfhi(g[m].z) + bfhi(ys[m].z); y1[2] = y1[2] * bflo(g[m].w) + bflo(ys[m].w); y1[3] = y1[3] * bfhi(g[m].w) + bfhi(ys[m].w);
                        u32x4 w; w.x = cvtpk(y0[0], y0[1]); w.y = cvtpk(y0[2], y0[3]); w.z = cvtpk(y1[0], y1[1]); w.w = cvtpk(y1[2], y1[3]);
                        if (sub < 5) *(u32x4*)(ysc + e * 8192 + to) = w;
                        else *(u32x4*)(Ys + (size_t)(row0 + ai * 128 + m * 16) * D + c0 + bj * 128) = w; }
                    __builtin_amdgcn_sched_barrier(0);
                }
        }
    }
};

DI float wave_sum(float v) {
#pragma unroll
    for (int o = 1; o < 64; o <<= 1) v += __shfl_xor(v, o);
    return v;
}
struct Ptrs {
    const float *x, *c, *ctx, *c_ctx, *w_ada, *b_ada, *g_pre_mix, *g_post_mix, *g_pre_ffn, *g_post_ffn, *w_in, *lam_q1, *lam_k1, *lam_q2, *lam_k2,
        *att_subln_g, *gm_ln_g, *gm_ln_b, *gm_ws, *gm_bs, *hg_lb, *hg_norm_g, *w_br_att, *w_br_gm, *w_br_hg, *w_out, *w_up, *conv_w, *conv_b, *w_down;
    float* out; unsigned char* ws;
};

DI const void* karg_load(int off) {
    const volatile __attribute__((address_space(4))) unsigned long long* p = (const volatile __attribute__((address_space(4))) unsigned long long*)((const __attribute__((address_space(4))) char*)__builtin_amdgcn_kernarg_segment_ptr() + off);
    return (const void*)(*p);
}
#define KP(name) ((const float*)karg_load((int)__builtin_offsetof(Ptrs, name)))
#define KWS() ((unsigned char*)karg_load((int)__builtin_offsetof(Ptrs, ws)))
#define KOUT() ((float*)karg_load((int)__builtin_offsetof(Ptrs, out)))

DI void transpose_item(const float* W, int K, int Nsrc, int src0, bf16_t* WT, int dst0, int k0, bool perm, LAS float* scr, int lane) {
    { float wv[32];
#pragma unroll
      for (int i = 0; i < 32; ++i) wv[i] = W[(size_t)(k0 + 2 * i + (lane >> 5)) * Nsrc + src0 + (lane & 31)];
#pragma unroll
      for (int i = 0; i < 32; ++i) scr[(2 * i + (lane >> 5)) * 33 + (lane & 31)] = wv[i]; }
    asm volatile("s_waitcnt lgkmcnt(0)" ::: "memory");
    const int c = lane & 7;
#pragma unroll
    for (int j = 0; j < 4; ++j) { const int n = (lane >> 3) + 8 * j;
        int ns = n; if (perm) { const int f = n >> 3, i = n & 7; ns = 4 * f + (i & 3) + 16 * (i >> 2); }
        const LAS float* s = scr + (8 * c) * 33 + ns;
        u32x4 o; o.x = cvtpk(s[0 * 33], s[1 * 33]); o.y = cvtpk(s[2 * 33], s[3 * 33]); o.z = cvtpk(s[4 * 33], s[5 * 33]); o.w = cvtpk(s[6 * 33], s[7 * 33]);
        *(u32x4*)(WT + (size_t)(dst0 + n) * K + k0 + 8 * c) = o; }
    asm volatile("s_waitcnt lgkmcnt(0)" ::: "memory");
}
DI void convert_weights(int l, LAS unsigned char* lds, int NGW) {
    const int tid = opaque_tid(), lane = tid & 63, wave = __builtin_amdgcn_readfirstlane(tid >> 6); const int gw = blockIdx.x * NWAVES + wave;
    LAS float* scr = (LAS float*)(lds + wave * 16384);
    unsigned char* ws = KWS();
    constexpr int I_IN = 416 * 16, I_BR = 32 * 16, I_UP = 176 * 16, I_DN = 32 * 44;
    constexpr int NIT = I_IN + 4 * I_BR + I_UP + I_DN;
    for (int it = gw; it < NIT; it += NGW) {
        int r = it;
        if (r < I_IN) { const int kb = r / 416, nb = r % 416; const int db = nb >> 5;
            const int sb = (db < 5) ? (5 + db) : (db < 10 ? (db - 5) : db);
            transpose_item(KP(w_in) + (size_t)l * D * 13312, D, 13312, sb * 1024 + (nb & 31) * 32, (bf16_t*)(ws + WS_WIN), nb * 32, kb * 64, (db == 5 || db == 6), scr, lane); continue; }
        r -= I_IN;
        if (r < 4 * I_BR) { const int j = r / I_BR, rr = r % I_BR; const int kb = rr / 32, nb = rr % 32;
            const float* W = (j == 0 ? KP(w_br_att) : j == 1 ? KP(w_br_gm) : j == 2 ? KP(w_br_hg) : KP(w_out)) + (size_t)l * D * D;
            bf16_t* dst = (bf16_t*)(ws + (j < 3 ? WS_WBR + (size_t)j * 2 * MiB : WS_WOUT));
            transpose_item(W, D, D, nb * 32, dst, nb * 32, kb * 64, false, scr, lane); continue; }
        r -= 4 * I_BR;
        if (r < I_UP) { const int kb = r / 176, nb = r % 176; const int j0 = nb * 32; const int hf = j0 / DFF, jj = j0 % DFF;
            const int src = (jj < DFFH) ? (DFFH * hf + jj) : (DFF + DFFH * hf + (jj - DFFH));
            transpose_item(KP(w_up) + (size_t)l * D * 2 * DFF, D, 2 * DFF, src, (bf16_t*)(ws + WS_WUP), j0, kb * 64, false, scr, lane); continue; }
        r -= I_UP;
        { const int kb = r / 32, nb = r % 32;
          transpose_item(KP(w_down) + (size_t)l * DFF * D, DFF, D, nb * 32, (bf16_t*)(ws + WS_WDN), nb * 32, kb * 64, false, scr, lane); }
    }
}

struct RW {
    const float* xin_lat; const float* xin_ctx; float* xo_lat; float* xo_ctx;
    const bf16_t* Y; const float* g_post; const float* modA; int gate_chunk;
    const float* g_pre; const float* modB; int sh_chunk; bf16_t* H; int skipctx;
};
DI void rw_phase(const RW& a, int NGW) {
    const int tid = opaque_tid(), lane = tid & 63; const int gw = blockIdx.x * NWAVES + __builtin_amdgcn_readfirstlane(tid >> 6);
    int r = gw;
    if (a.skipctx) { while (r < M && (r % TP) >= TL) r += NGW; }
    f32x4 xn[4], yn[4];
#define RW_LOAD(rr) do { const int b_ = (rr) / TP, p_ = (rr) - b_ * TP; const bool c_ = p_ >= TL; const size_t xo_ = c_ ? (size_t)(b_ * LC + p_ - TL) * D : (size_t)(b_ * TL + p_) * D; \
        const float* xi_ = (c_ ? a.xin_ctx : a.xin_lat) + xo_; _Pragma("unroll") for (int j = 0; j < 4; ++j) xn[j] = *(const f32x4*)(xi_ + 4 * lane + 256 * j); \
        if (a.Y) { const bf16_t* yr_ = a.Y + (size_t)(rr) * D; _Pragma("unroll") for (int j = 0; j < 4; ++j) { const u32x2 w_ = *(const u32x2*)(yr_ + 4 * lane + 256 * j); yn[j] = (f32x4){bflo(w_.x), bfhi(w_.x), bflo(w_.y), bfhi(w_.y)}; } } } while (0)
    if (r < M) RW_LOAD(r);
    f32x4 gpo[4], gpr[4];
#pragma unroll
    for (int j = 0; j < 4; ++j) { gpo[j] = a.Y ? *(const f32x4*)(a.g_post + 4 * lane + 256 * j) : (f32x4){0.f, 0.f, 0.f, 0.f}; gpr[j] = a.H ? *(const f32x4*)(a.g_pre + 4 * lane + 256 * j) : (f32x4){0.f, 0.f, 0.f, 0.f}; }
    while (r < M) {
        const int b = r / TP, p = r - b * TP; const bool isctx = p >= TL;
        const size_t xoff = isctx ? (size_t)(b * LC + p - TL) * D : (size_t)(b * TL + p) * D;
        const int mr = isctx ? 8 : b;
        f32x4 x[4], y[4];
#pragma unroll
        for (int j = 0; j < 4; ++j) { x[j] = xn[j]; y[j] = yn[j]; }
        int rn = r + NGW;
        if (a.skipctx) { while (rn < M && (rn % TP) >= TL) rn += NGW; }
        if (rn < M) RW_LOAD(rn);
        f32x4 gq[4], s1q[4], s2q[4];
        if (a.Y) { const float* gt = a.modA + (size_t)mr * 6144 + a.gate_chunk * 1024;
#pragma unroll
            for (int j = 0; j < 4; ++j) gq[j] = *(const f32x4*)(gt + 4 * lane + 256 * j); }
        if (a.H) { const float* sh = a.modB + (size_t)mr * 6144 + a.sh_chunk * 1024;
#pragma unroll
            for (int j = 0; j < 4; ++j) { s1q[j] = *(const f32x4*)(sh + 4 * lane + 256 * j); s2q[j] = *(const f32x4*)(sh + 1024 + 4 * lane + 256 * j); } }
        if (a.Y) {
            float ss = 0.f;
#pragma unroll
            for (int j = 0; j < 4; ++j) ss += (y[j][0] * y[j][0] + y[j][1] * y[j][1]) + (y[j][2] * y[j][2] + y[j][3] * y[j][3]);
            const float rs = rsqrtf(wave_sum(ss) * (1.f / D) + EPS);
            float* xo = (isctx ? a.xo_ctx : a.xo_lat) + xoff;
#pragma unroll
            for (int j = 0; j < 4; ++j) { x[j] = x[j] + gq[j] * (y[j] * rs * gpo[j]); *(f32x4*)(xo + 4 * lane + 256 * j) = x[j]; }
        }
        if (a.H) {
            float ss = 0.f;
#pragma unroll
            for (int j = 0; j < 4; ++j) ss += (x[j][0] * x[j][0] + x[j][1] * x[j][1]) + (x[j][2] * x[j][2] + x[j][3] * x[j][3]);
            const float rs = rsqrtf(wave_sum(ss) * (1.f / D) + EPS);
            bf16_t* hr = a.H + (size_t)r * D;
#pragma unroll
            for (int j = 0; j < 4; ++j) { const f32x4 h = (x[j] * rs * gpr[j]) * (s2q[j] + 1.f) + s1q[j];
                u32x2 w; w.x = cvtpk(h[0], h[1]); w.y = cvtpk(h[2], h[3]); *(u32x2*)(hr + 4 * lane + 256 * j) = w; }
        }
        r = rn;
    }
#undef RW_LOAD
}

DI void p0_tables(LAS unsigned char* lds) {
    const int tid = opaque_tid();
    unsigned char* ws0 = KWS(); float* mod = (float*)(ws0 + TAB_MOD);
    const float* pc = KP(c); const float* pcc = KP(c_ctx); const float* pwa = KP(w_ada); const float* pba = KP(b_ada);
    LAS float* sc = (LAS float*)lds;
    LAS float* part = (LAS float*)(lds + 40960);
    for (int it = blockIdx.x; it < 192; it += gridDim.x) {
        const int l = it / 96, n0 = (it % 96) * 64;
        __syncthreads();
        for (int i = tid; i < 9 * 1024; i += NTHR) { const int r = i >> 10, k = i & 1023; const float v = (r < 8) ? pc[r * 1024 + k] : pcc[k]; sc[i] = v / (1.f + __expf(-v)); }
        __syncthreads();
        const int col = tid & 63, ks = tid >> 6;
        float a[9];
#pragma unroll
        for (int r = 0; r < 9; ++r) a[r] = 0.f;
        const float* w = pwa + (size_t)l * D * 6144 + n0 + col;
        for (int k0 = ks * 128; k0 < ks * 128 + 128; k0 += 16) { float wv[16];
#pragma unroll
            for (int j = 0; j < 16; ++j) wv[j] = w[(size_t)(k0 + j) * 6144];
#pragma unroll
            for (int j = 0; j < 16; ++j)
#pragma unroll
                for (int r = 0; r < 9; ++r) a[r] += sc[r * 1024 + k0 + j] * wv[j]; }
#pragma unroll
        for (int r = 0; r < 9; ++r) part[(ks * 9 + r) * 64 + col] = a[r];
        __syncthreads();
        for (int i = tid; i < 576; i += NTHR) { const int r = i >> 6, cc = i & 63; float s = 0.f;
#pragma unroll
            for (int q = 0; q < 8; ++q) s += part[(q * 9 + r) * 64 + cc];
            mod[((size_t)l * 9 + r) * 6144 + n0 + cc] = s + pba[l * 6144 + n0 + cc]; }
    }
    if (blockIdx.x == gridDim.x - 1) {
        float* rope = (float*)(ws0 + TAB_ROPE); float* lb = (float*)(ws0 + TAB_LB); float* lam = (float*)(ws0 + TAB_LAM);
        const float* phl = KP(hg_lb); const float* q1 = KP(lam_q1); const float* k1 = KP(lam_k1); const float* q2 = KP(lam_q2); const float* k2 = KP(lam_k2);
        for (int i = tid; i < 1024; i += NTHR) { const int pos = i >> 4, f = i & 15; const float inv = exp2f(-(float)f * (13.287712379549449f / 16.f)); const float ang = (float)pos * inv;
            rope[i] = cosf(ang); rope[1024 + i] = sinf(ang); }
        for (int i = tid; i < 2048; i += NTHR) { lb[i] = 0.f; const float l0 = phl[i], l1 = phl[2048 + i]; lb[2048 + i] = 1.f / (1.f + expf(l0 - l1)); }
        if (tid < 2) { const int l = tid; float s1 = 0.f, s2 = 0.f; for (int i = 0; i < 64; ++i) { s1 += q1[l * 64 + i] * k1[l * 64 + i]; s2 += q2[l * 64 + i] * k2[l * 64 + i]; }
            const float li = 0.8f - 0.6f * expf(-0.3f * (float)l); lam[l] = expf(s1) - expf(s2) + li; lam[2 + l] = li; }
    }
}

constexpr int SC_QH = 0, SC_KH = 17408, SC_KT = 34816, SC_VT = 53248, SC_ST = 71680, SC_VEC = 106496, SC_QT = 108032;
DI void scan_phase(unsigned char* sl, int layer, bool ctx_out, bool do_store, LAS unsigned char* lds) {
    const int wg = blockIdx.x; if (wg >= 128) return;
    const int tid = opaque_tid(), lane = tid & 63, wid = __builtin_amdgcn_readfirstlane(tid >> 6), r32 = lane & 31, hh = lane >> 5;
    const int dir = wg & 1, h = (wg >> 1) & 7, b = wg >> 4;
    const bf16_t* Qs = (const bf16_t*)(sl + 1 * SLAB); bf16_t* Gs = (bf16_t*)(sl + (size_t)(2 + dir) * SLAB); const bf16_t* Vs = (const bf16_t*)(sl + 4 * SLAB);
    const int kp = tid & 63, oct = tid >> 6;
    const size_t colp = (size_t)h * 128 + 2 * kp;
    f32x16 sacc[2];
#pragma unroll
    for (int t = 0; t < 2; ++t)
#pragma unroll
        for (int i = 0; i < 16; ++i) sacc[t][i] = 0.f;
    const int vb = wid & 3, kb0 = 2 * (wid >> 2), tb = wid >> 2;
    LAS float* vec = (LAS float*)(lds + SC_VEC); LAS float* qt = (LAS float*)(lds + SC_QT);
#define SC_ROW0(ci_) (((ci_) < 4) ? (b * TP + TL + 64 * (dir ? 3 - (ci_) : (ci_))) : (b * TP + 64 * (dir ? 63 - ((ci_) - 4) : ((ci_) - 4))))
#define SC_LOAD(r0_) do { _Pragma("unroll") for (int j = 0; j < 8; ++j) { const int tau = 8 * oct + j; const size_t ro = (size_t)((r0_) + (dir ? 63 - tau : tau)) * D + colp; \
            lw[j] = *(const unsigned*)(Gs + ro); qw[j] = *(const unsigned*)(Qs + ro); vw[j] = *(const unsigned*)(Vs + ro); } } while (0)
    unsigned lw[8], qw[8], vw[8];
    SC_LOAD(SC_ROW0(0));
    for (int ci = 0; ci < 68; ++ci) {
        const int row0 = SC_ROW0(ci); const bool need_out = (ci < 4) ? ctx_out : true;
        float c0 = 0.f, c1 = 0.f; float A0[8], A1[8];
#pragma unroll
        for (int j = 0; j < 8; ++j) { c0 += bflo(lw[j]); c1 += bfhi(lw[j]); A0[j] = c0; A1[j] = c1; }
        *(LAS f32x2_t*)(qt + oct * 128 + 2 * kp) = (f32x2_t){c0, c1};
        __syncthreads();
        float of0 = 0.f, of1 = 0.f, ar0 = 0.f, ar1 = 0.f, al0 = 0.f, al1 = 0.f;
#pragma unroll
        for (int o = 0; o < 8; ++o) { const f32x2_t tq = *(const LAS f32x2_t*)(qt + o * 128 + 2 * kp);
            if (o < oct) { of0 += tq.x; of1 += tq.y; } if (o < 4) { ar0 += tq.x; ar1 += tq.y; } al0 += tq.x; al1 += tq.y; }
        if (oct == 0) { *(LAS f32x2_t*)(vec + 2 * kp) = (f32x2_t){__expf(ar0), __expf(ar1)}; *(LAS f32x2_t*)(vec + 128 + 2 * kp) = (f32x2_t){__expf(al0), __expf(al1)};
            *(LAS f32x2_t*)(vec + 256 + 2 * kp) = (f32x2_t){__expf(al0 - ar0), __expf(al1 - ar1)}; }
        unsigned kt0[4], kt1[4];
        float kprev0 = 0.f, kprev1 = 0.f;
#pragma unroll
        for (int j = 0; j < 8; ++j) {
            const float a0 = of0 + A0[j], a1 = of1 + A1[j];
            const float l0 = bflo(lw[j]), l1 = bfhi(lw[j]);
            const float qh0 = bflo(qw[j]) * __expf(fminf(a0 - ar0, 80.f)), qh1 = bfhi(qw[j]) * __expf(fminf(a1 - ar1, 80.f));
            const float kh0 = (1.f - __expf(l0)) * __expf(fminf(ar0 - a0, 80.f)), kh1 = (1.f - __expf(l1)) * __expf(fminf(ar1 - a1, 80.f));
            const int tau = 8 * oct + j;
            *(LAS unsigned*)(lds + SC_QH + tau * 272 + kp * 4) = cvtpk(qh0, qh1);
            *(LAS unsigned*)(lds + SC_KH + tau * 272 + kp * 4) = cvtpk(kh0, kh1);
            if (j & 1) { kt0[j >> 1] = cvtpk(kprev0, kh0); kt1[j >> 1] = cvtpk(kprev1, kh1); } else { kprev0 = kh0; kprev1 = kh1; }
        }
        *(LAS u32x4*)(lds + SC_KT + (2 * kp) * 144 + oct * 16) = (u32x4){kt0[0], kt0[1], kt0[2], kt0[3]};
        *(LAS u32x4*)(lds + SC_KT + (2 * kp + 1) * 144 + oct * 16) = (u32x4){kt1[0], kt1[1], kt1[2], kt1[3]};
        { u32x4 v0, v1;
#pragma unroll
          for (int e = 0; e < 4; ++e) { v0[e] = (vw[2 * e] & 0xffffu) | (vw[2 * e + 1] << 16); v1[e] = (vw[2 * e] >> 16) | (vw[2 * e + 1] & 0xffff0000u); }
          *(LAS u32x4*)(lds + SC_VT + (2 * kp) * 144 + oct * 16) = v0; *(LAS u32x4*)(lds + SC_VT + (2 * kp + 1) * 144 + oct * 16) = v1; }
        if (ci + 1 < 68) SC_LOAD(SC_ROW0(ci + 1));
        __syncthreads();
#pragma unroll
        for (int t = 0; t < 2; ++t)
#pragma unroll
            for (int g = 0; g < 4; ++g) { const int k0 = 32 * (kb0 + t) + 8 * g + 4 * hh; const f32x4 ea = *(const LAS f32x4*)(vec + k0);
                u32x2 w; w.x = cvtpk(sacc[t][4 * g] * ea[0], sacc[t][4 * g + 1] * ea[1]); w.y = cvtpk(sacc[t][4 * g + 2] * ea[2], sacc[t][4 * g + 3] * ea[3]);
                *(LAS u32x2*)(lds + SC_ST + (32 * vb + r32) * 272 + k0 * 2) = w; }
        __syncthreads();
        f32x16 d1[2];
#pragma unroll
        for (int t = 0; t < 2; ++t) {
#pragma unroll
            for (int i = 0; i < 16; ++i) d1[t][i] = 0.f;
#pragma unroll
            for (int s = 0; s < 4; ++s) { const bf16x8 af = *(const LAS bf16x8*)(lds + SC_KT + (32 * (kb0 + t) + r32) * 144 + (16 * s + 8 * hh) * 2);
                const bf16x8 bfv = *(const LAS bf16x8*)(lds + SC_VT + (32 * vb + r32) * 144 + (16 * s + 8 * hh) * 2);
                d1[t] = MFMA32(af, bfv, d1[t]); }
        }
        if (need_out) {
            f32x16 o, p0, p1;
#pragma unroll
            for (int i = 0; i < 16; ++i) { o[i] = 0.f; p0[i] = 0.f; p1[i] = 0.f; }
            bf16x8 qf[8];
#pragma unroll
            for (int s = 0; s < 8; ++s) qf[s] = *(const LAS bf16x8*)(lds + SC_QH + (32 * tb + r32) * 272 + (16 * s + 8 * hh) * 2);
            if (tb == 1) {
#pragma unroll
                for (int s = 0; s < 8; ++s) { const bf16x8 sf = *(const LAS bf16x8*)(lds + SC_ST + (32 * vb + r32) * 272 + (16 * s + 8 * hh) * 2);
                    const bf16x8 k0 = *(const LAS bf16x8*)(lds + SC_KH + r32 * 272 + (16 * s + 8 * hh) * 2), k1 = *(const LAS bf16x8*)(lds + SC_KH + (32 + r32) * 272 + (16 * s + 8 * hh) * 2);
                    o = MFMA32(sf, qf[s], o); p0 = MFMA32(k0, qf[s], p0); p1 = MFMA32(k1, qf[s], p1); }
#pragma unroll
                for (int i = 0; i < 16; ++i) if (crow(i, hh) > r32) p1[i] = 0.f;
            } else {
#pragma unroll
                for (int s = 0; s < 8; ++s) { const bf16x8 sf = *(const LAS bf16x8*)(lds + SC_ST + (32 * vb + r32) * 272 + (16 * s + 8 * hh) * 2);
                    const bf16x8 k0 = *(const LAS bf16x8*)(lds + SC_KH + r32 * 272 + (16 * s + 8 * hh) * 2);
                    o = MFMA32(sf, qf[s], o); p0 = MFMA32(k0, qf[s], p0); }
#pragma unroll
                for (int i = 0; i < 16; ++i) if (crow(i, hh) > r32) p0[i] = 0.f;
            }
#define SC_PV(PT, SB) do { _Pragma("unroll") for (int s = 0; s < 2; ++s) { \
                    u32x4 pa; pa.x = cvtpk(PT[8 * s], PT[8 * s + 1]); pa.y = cvtpk(PT[8 * s + 2], PT[8 * s + 3]); pa.z = cvtpk(PT[8 * s + 4], PT[8 * s + 5]); pa.w = cvtpk(PT[8 * s + 6], PT[8 * s + 7]); \
                    const u32x2 lo = *(const LAS u32x2*)(lds + SC_VT + (32 * vb + r32) * 144 + (32 * (SB) + 16 * s + 4 * hh) * 2); \
                    const u32x2 hi = *(const LAS u32x2*)(lds + SC_VT + (32 * vb + r32) * 144 + (32 * (SB) + 16 * s + 8 + 4 * hh) * 2); \
                    const u32x4 vbv = {lo.x, lo.y, hi.x, hi.y}; \
                    o = MFMA32(__builtin_bit_cast(bf16x8, vbv), __builtin_bit_cast(bf16x8, pa), o); } } while (0)
            SC_PV(p0, 0);
            if (tb == 1) SC_PV(p1, 1);
#undef SC_PV
            { const int tau = 32 * tb + r32; const size_t ro = (size_t)(row0 + (dir ? 63 - tau : tau)) * D + h * 128 + 32 * vb + 4 * hh;
#pragma unroll
              for (int g4 = 0; g4 < 4; ++g4) { u32x2 w; w.x = cvtpk(o[4 * g4], o[4 * g4 + 1]); w.y = cvtpk(o[4 * g4 + 2], o[4 * g4 + 3]);
                  if (do_store) *(u32x2*)(Gs + ro + 8 * g4) = w; } }
        }
#pragma unroll
        for (int t = 0; t < 2; ++t)
#pragma unroll
            for (int g = 0; g < 4; ++g) { const int k0 = 32 * (kb0 + t) + 8 * g + 4 * hh; const f32x4 aS = *(const LAS f32x4*)(vec + 128 + k0), bS = *(const LAS f32x4*)(vec + 256 + k0);
#pragma unroll
                for (int e = 0; e < 4; ++e) sacc[t][4 * g + e] = aS[e] * sacc[t][4 * g + e] + bS[e] * d1[t][4 * g + e]; }
        __syncthreads();
    }
}

DI void combine_phase(unsigned char* sl, const float* gnorm, bool skipctx, int NGW) {
    const int tid = opaque_tid(), lane = tid & 63; const int gw = blockIdx.x * NWAVES + __builtin_amdgcn_readfirstlane(tid >> 6);
    const bf16_t* Of = (const bf16_t*)(sl + 2 * SLAB); const bf16_t* Ob = (const bf16_t*)(sl + 3 * SLAB); const bf16_t* Hg = (const bf16_t*)(sl + 5 * SLAB); bf16_t* Y = (bf16_t*)(sl + 1 * SLAB);
    const int c16 = (lane & 7) * 16;
    float g[16];
#pragma unroll
    for (int i = 0; i < 16; ++i) g[i] = gnorm[c16 + i];
    int r = gw;
    if (skipctx) { while (r < M && (r % TP) >= TL) r += NGW; }
    u32x4 na0, na1, nb0, nb1, nh0, nh1;
#define CB_LOAD(rr) do { const size_t o_ = (size_t)(rr) * D + lane * 16; na0 = *(const u32x4*)(Of + o_); na1 = *(const u32x4*)(Of + o_ + 8); nb0 = *(const u32x4*)(Ob + o_); nb1 = *(const u32x4*)(Ob + o_ + 8); nh0 = *(const u32x4*)(Hg + o_); nh1 = *(const u32x4*)(Hg + o_ + 8); } while (0)
    if (r < M) CB_LOAD(r);
    while (r < M) {
        const size_t off = (size_t)r * D + lane * 16;
        const u32x4 a0 = na0, a1 = na1, b0 = nb0, b1 = nb1, h0 = nh0, h1 = nh1;
        int rn = r + NGW;
        if (skipctx) { while (rn < M && (rn % TP) >= TL) rn += NGW; }
        if (rn < M) CB_LOAD(rn);
        float o[16], hg[16];
#pragma unroll
        for (int i = 0; i < 4; ++i) { o[2 * i] = bflo(a0[i]) + bflo(b0[i]); o[2 * i + 1] = bfhi(a0[i]) + bfhi(b0[i]); o[8 + 2 * i] = bflo(a1[i]) + bflo(b1[i]); o[8 + 2 * i + 1] = bfhi(a1[i]) + bfhi(b1[i]);
            hg[2 * i] = bflo(h0[i]); hg[2 * i + 1] = bfhi(h0[i]); hg[8 + 2 * i] = bflo(h1[i]); hg[8 + 2 * i + 1] = bfhi(h1[i]); }
        float ss = 0.f;
#pragma unroll
        for (int i = 0; i < 16; ++i) ss += o[i] * o[i];
        ss += __shfl_xor(ss, 1); ss += __shfl_xor(ss, 2); ss += __shfl_xor(ss, 4);
        const float rs = rsqrtf(ss * (1.f / 128.f) + EPS);
        u32x4 w0, w1;
#pragma unroll
        for (int i = 0; i < 4; ++i) { w0[i] = cvtpk(o[2 * i] * rs * g[2 * i] * hg[2 * i], o[2 * i + 1] * rs * g[2 * i + 1] * hg[2 * i + 1]);
            w1[i] = cvtpk(o[8 + 2 * i] * rs * g[8 + 2 * i] * hg[8 + 2 * i], o[8 + 2 * i + 1] * rs * g[8 + 2 * i + 1] * hg[8 + 2 * i + 1]); }
        *(u32x4*)(Y + off) = w0; *(u32x4*)(Y + off + 8) = w1;
        r = rn;
    }
#undef CB_LOAD
}

constexpr int AT_KP = 144, AT_VP = 320, AT_KB = 2 * 64 * AT_KP, AT_BUF = AT_KB + 64 * AT_VP;
DI void attn_unit(const bf16_t* Q, const bf16_t* Kp, const bf16_t* Vp, bf16_t* O, size_t qrow0, size_t krow0, int ntile, int h, float lam, float lam_init, const float* gsub, LAS unsigned char* lds) {
    const int tid = opaque_tid(), lane = tid & 63, wid = __builtin_amdgcn_readfirstlane(tid >> 6), r32 = lane & 31, hh = lane >> 5;
    const int sub = wid & 1, qg = wid >> 1;
    constexpr int KRING = 0, VRING = 65536, SLOT = 16384;
    bf16x8 qf[4];
    { const bf16_t* qp = Q + (qrow0 + 32 * qg + r32) * D + h * 128 + sub * 64 + 8 * hh;
#pragma unroll
      for (int d0 = 0; d0 < 4; ++d0) qf[d0] = *(const bf16x8*)(qp + 16 * d0); }
    f32x16 ot[4];
#pragma unroll
    for (int d = 0; d < 4; ++d)
#pragma unroll
        for (int i = 0; i < 16; ++i) ot[d][i] = 0.f;
    float m_run = -1e30f, l_run = 0.f;
    const char* kbu = (const char*)(Kp + krow0 * D + h * 128); const char* vbu = (const char*)(Vp + krow0 * D + h * 128);
    unsigned kso, vso0, vso1;
    { const int kr = 8 * wid + (lane >> 3); const int kc = (lane & 7) ^ ((kr >> 1) & 7); kso = (unsigned)((kr * D + kc * 8) * 2);
      const int vr0 = 4 * wid + (lane >> 4), vr1 = vr0 + 32; const int vc = (lane & 15) ^ (4 * (vr0 & 3));
      vso0 = (unsigned)((vr0 * D + vc * 8) * 2); vso1 = (unsigned)((vr1 * D + vc * 8) * 2); }
    const unsigned ldsb = (unsigned)(unsigned long)lds;
#define AT_DMA(gp, ldsoff) do { unsigned keep_; const unsigned dst_ = (unsigned)__builtin_amdgcn_readfirstlane((int)(ldsb + (unsigned)(ldsoff))); \
        asm volatile("s_mov_b32 %0, m0\n\ts_mov_b32 m0, %2\n\ts_nop 0\n\tglobal_load_lds_dwordx4 %1, off\n\ts_mov_b32 m0, %0" : "=&s"(keep_) : "v"(gp), "s"(dst_) : "memory"); } while (0)
#define AT_ISSUE_K(tile, slot) do { const char* g_ = kbu + (size_t)(tile) * (64 * D * 2) + kso; AT_DMA(g_, KRING + (slot) * SLOT + wid * 1024); AT_DMA(g_ + 128, KRING + (slot) * SLOT + 8192 + wid * 1024); } while (0)
#define AT_ISSUE_V(tile, slot) do { const char* g_ = vbu + (size_t)(tile) * (64 * D * 2); AT_DMA(g_ + vso0, VRING + (slot) * SLOT + wid * 1024); AT_DMA(g_ + vso1, VRING + (slot) * SLOT + 8192 + wid * 1024); } while (0)
    asm volatile("s_waitcnt lgkmcnt(0)" ::: "memory"); __builtin_amdgcn_s_barrier();
    AT_ISSUE_K(0, 0); AT_ISSUE_K(1, 1); AT_ISSUE_K(2, 2); AT_ISSUE_K(3, 3); AT_ISSUE_V(0, 0); AT_ISSUE_V(1, 1);
    { const u32x4 z = {0u, 0u, 0u, 0u}; *(LAS u32x4*)(lds + VRING + 3 * SLOT + tid * 16) = z; *(LAS u32x4*)(lds + VRING + 3 * SLOT + 8192 + tid * 16) = z; }
    asm volatile("s_waitcnt vmcnt(0) lgkmcnt(0)" ::: "memory"); __builtin_amdgcn_s_barrier(); asm volatile("" ::: "memory");
    const int q4 = (lane & 15) >> 2, p4 = lane & 3, blk = (lane >> 4) & 1;
    const int ksw = (r32 >> 1) & 7;
    const int kro = sub * 8192 + r32 * 128;
    const int vro = (4 * hh + q4) * 256 + blk * 32 + p4 * 8;
    f32x16 sc[2], sn[2];
#pragma unroll
    for (int kh = 0; kh < 2; ++kh) {
#pragma unroll
        for (int i = 0; i < 16; ++i) sc[kh][i] = 0.f;
#pragma unroll
        for (int d0 = 0; d0 < 4; ++d0) { const bf16x8 kf = *(const LAS bf16x8*)(lds + KRING + kro + kh * 4096 + (((2 * d0 + hh) ^ ksw) * 16)); sc[kh] = MFMA32(kf, qf[d0], sc[kh]); }
    }
    u32x4 pp[4];
#pragma unroll
    for (int j = 0; j < 4; ++j) pp[j] = (u32x4){0u, 0u, 0u, 0u};
    constexpr float AT_TRIG = 16384.f;
    f32x16 negm;
    { float mx = fmaxf(fmaxf(sc[0][0], sc[0][1]), sc[0][2]);
#pragma unroll
      for (int i = 3; i < 15; i += 2) mx = fmaxf(fmaxf(mx, sc[0][i]), sc[0][i + 1]);
      mx = fmaxf(mx, sc[0][15]);
#pragma unroll
      for (int i = 0; i < 16; i += 2) mx = fmaxf(fmaxf(mx, sc[1][i]), sc[1][i + 1]);
      mx = fmaxf(mx, __shfl_xor(mx, 32));
#pragma unroll
      for (int i = 0; i < 16; ++i) { negm[i] = -mx; sc[0][i] -= mx; sc[1][i] -= mx; } }
    asm volatile("s_waitcnt lgkmcnt(0)" ::: "memory"); __builtin_amdgcn_s_barrier(); asm volatile("" ::: "memory");
    const bool shifted = wid >= 4;
    float ps = 0.f;
    if (shifted) {
#pragma unroll
        for (int kh = 0; kh < 2; ++kh)
#pragma unroll
            for (int i = 0; i < 16; ++i) { sc[kh][i] = __builtin_amdgcn_exp2f(sc[kh][i]); ps += sc[kh][i]; }
        l_run += ps;
    }
    int ks0 = 0, ks1 = 1, vsm1 = 3, vs1 = 2;
    for (int t = 0; t < ntile; t += 2) {
      {
        { const int tk = (t + 4 < ntile) ? t + 4 : ntile - 1; AT_ISSUE_K(tk, ks0); const int tv = (t + 2 < ntile) ? t + 2 : ntile - 1; AT_ISSUE_V(tv, vs1); }
        LAS unsigned char* kb = lds + KRING + ks1 * SLOT + kro;
        LAS unsigned char* vb = lds + VRING + vsm1 * SLOT + vro;
        __builtin_amdgcn_s_setprio(1);
        { bf16x8 ql[4];
#pragma unroll
          for (int d0 = 0; d0 < 4; ++d0) ql[d0] = qf[d0];
#pragma unroll
          for (int kh = 0; kh < 2; ++kh) {
            bf16x8 kf[4];
#pragma unroll
            for (int e = 0; e < 4; ++e) kf[e] = *(const LAS bf16x8*)(kb + kh * 4096 + (((2 * e + hh) ^ ksw) * 16));
            sn[kh] = MFMA32(kf[0], ql[0], negm);
#pragma unroll
            for (int d0 = 1; d0 < 4; ++d0) sn[kh] = MFMA32(kf[d0], ql[d0], sn[kh]);
            __builtin_amdgcn_sched_barrier(0);
          } }
#pragma unroll
        for (int j = 0; j < 4; ++j) {
            s16x4 lo[4], hi[4];
#pragma unroll
            for (int e = 0; e < 4; ++e) { LAS unsigned char* vp = vb + j * 4096 + ((e ^ q4) * 64);
                lo[e] = __builtin_bit_cast(s16x4, __builtin_amdgcn_ds_read_tr16_b64_v4i16((LAS s16x4*)vp));
                hi[e] = __builtin_bit_cast(s16x4, __builtin_amdgcn_ds_read_tr16_b64_v4i16((LAS s16x4*)(vp + 2048))); }
#pragma unroll
            for (int e = 0; e < 4; ++e) ot[e] = MFMA32(__builtin_shufflevector(lo[e], hi[e], 0, 1, 2, 3, 4, 5, 6, 7), __builtin_bit_cast(bf16x8, pp[j]), ot[e]);
            __builtin_amdgcn_sched_barrier(0);
        }
        __builtin_amdgcn_s_setprio(0);
        if (!shifted) {
            ps = 0.f;
#pragma unroll
            for (int kh = 0; kh < 2; ++kh)
#pragma unroll
                for (int i = 0; i < 16; ++i) { sc[kh][i] = __builtin_amdgcn_exp2f(sc[kh][i]); ps += sc[kh][i]; }
            l_run += ps;
        }
        if (__builtin_amdgcn_ballot_w64(ps > AT_TRIG) != 0ull) {
            float pm = fmaxf(fmaxf(sc[0][0], sc[0][1]), sc[0][2]);
#pragma unroll
            for (int i = 3; i < 15; i += 2) pm = fmaxf(fmaxf(pm, sc[0][i]), sc[0][i + 1]);
            pm = fmaxf(pm, sc[0][15]);
#pragma unroll
            for (int i = 0; i < 16; i += 2) pm = fmaxf(fmaxf(pm, sc[1][i]), sc[1][i + 1]);
            pm = fmaxf(pm, __shfl_xor(pm, 32));
            const bool mv = pm > 256.f; const float delta = mv ? __builtin_amdgcn_logf(pm) : 0.f; const float alpha = mv ? __builtin_amdgcn_rcpf(pm) : 1.f;
            l_run *= alpha;
#pragma unroll
            for (int i = 0; i < 16; ++i) negm[i] -= delta;
#pragma unroll
            for (int kh = 0; kh < 2; ++kh)
#pragma unroll
                for (int i = 0; i < 16; ++i) { sc[kh][i] *= alpha; sn[kh][i] -= delta; }
#pragma unroll
            for (int d = 0; d < 4; ++d)
#pragma unroll
                for (int i = 0; i < 16; ++i) ot[d][i] *= alpha;
        }
#pragma unroll
        for (int kh = 0; kh < 2; ++kh)
#pragma unroll
            for (int s2 = 0; s2 < 2; ++s2) { u32x4 pa; pa.x = cvtpk(sc[kh][8 * s2], sc[kh][8 * s2 + 1]); pa.y = cvtpk(sc[kh][8 * s2 + 2], sc[kh][8 * s2 + 3]); pa.z = cvtpk(sc[kh][8 * s2 + 4], sc[kh][8 * s2 + 5]); pa.w = cvtpk(sc[kh][8 * s2 + 6], sc[kh][8 * s2 + 7]);
                pp[2 * kh + s2] = pa; }
        { const int n0 = ks1; ks1 = (ks1 + 1) & 3; ks0 = n0; vsm1 = (vsm1 + 1) & 3; vs1 = (vs1 + 1) & 3; }
        asm volatile("s_waitcnt vmcnt(8) lgkmcnt(0)" ::: "memory"); __builtin_amdgcn_s_barrier(); asm volatile("" ::: "memory");
        if (shifted && t + 1 < ntile) {
            ps = 0.f;
#pragma unroll
            for (int kh = 0; kh < 2; ++kh)
#pragma unroll
                for (int i = 0; i < 16; ++i) { sn[kh][i] = __builtin_amdgcn_exp2f(sn[kh][i]); ps += sn[kh][i]; }
            l_run += ps;
        }
          }
      {
        const int t1 = t + 1;
        { const int tk = (t1 + 4 < ntile) ? t1 + 4 : ntile - 1; AT_ISSUE_K(tk, ks0); const int tv = (t1 + 2 < ntile) ? t1 + 2 : ntile - 1; AT_ISSUE_V(tv, vs1); }
        LAS unsigned char* kb = lds + KRING + ks1 * SLOT + kro;
        LAS unsigned char* vb = lds + VRING + vsm1 * SLOT + vro;
        __builtin_amdgcn_s_setprio(1);
        { bf16x8 ql[4];
#pragma unroll
          for (int d0 = 0; d0 < 4; ++d0) ql[d0] = qf[d0];
#pragma unroll
          for (int kh = 0; kh < 2; ++kh) {
            bf16x8 kf[4];
#pragma unroll
            for (int e = 0; e < 4; ++e) kf[e] = *(const LAS bf16x8*)(kb + kh * 4096 + (((2 * e + hh) ^ ksw) * 16));
            sc[kh] = MFMA32(kf[0], ql[0], negm);
#pragma unroll
            for (int d0 = 1; d0 < 4; ++d0) sc[kh] = MFMA32(kf[d0], ql[d0], sc[kh]);
            __builtin_amdgcn_sched_barrier(0);
          } }
#pragma unroll
        for (int j = 0; j < 4; ++j) {
            s16x4 lo[4], hi[4];
#pragma unroll
            for (int e = 0; e < 4; ++e) { LAS unsigned char* vp = vb + j * 4096 + ((e ^ q4) * 64);
                lo[e] = __builtin_bit_cast(s16x4, __builtin_amdgcn_ds_read_tr16_b64_v4i16((LAS s16x4*)vp));
                hi[e] = __builtin_bit_cast(s16x4, __builtin_amdgcn_ds_read_tr16_b64_v4i16((LAS s16x4*)(vp + 2048))); }
#pragma unroll
            for (int e = 0; e < 4; ++e) ot[e] = MFMA32(__builtin_shufflevector(lo[e], hi[e], 0, 1, 2, 3, 4, 5, 6, 7), __builtin_bit_cast(bf16x8, pp[j]), ot[e]);
            __builtin_amdgcn_sched_barrier(0);
        }
        __builtin_amdgcn_s_setprio(0);
        if (!shifted) {
            ps = 0.f;
#pragma unroll
            for (int kh = 0; kh < 2; ++kh)
#pragma unroll
                for (int i = 0; i < 16; ++i) { sn[kh][i] = __builtin_amdgcn_exp2f(sn[kh][i]); ps += sn[kh][i]; }
            l_run += ps;
        }
        if (__builtin_amdgcn_ballot_w64(ps > AT_TRIG) != 0ull) {
            float pm = fmaxf(fmaxf(sn[0][0], sn[0][1]), sn[0][2]);
#pragma unroll
            for (int i = 3; i < 15; i += 2) pm = fmaxf(fmaxf(pm, sn[0][i]), sn[0][i + 1]);
            pm = fmaxf(pm, sn[0][15]);
#pragma unroll
            for (int i = 0; i < 16; i += 2) pm = fmaxf(fmaxf(pm, sn[1][i]), sn[1][i + 1]);
            pm = fmaxf(pm, __shfl_xor(pm, 32));
            const bool mv = pm > 256.f; const float delta = mv ? __builtin_amdgcn_logf(pm) : 0.f; const float alpha = mv ? __builtin_amdgcn_rcpf(pm) : 1.f;
            l_run *= alpha;
#pragma unroll
            for (int i = 0; i < 16; ++i) negm[i] -= delta;
#pragma unroll
            for (int kh = 0; kh < 2; ++kh)
#pragma unroll
                for (int i = 0; i < 16; ++i) { sn[kh][i] *= alpha; sc[kh][i] -= delta; }
#pragma unroll
            for (int d = 0; d < 4; ++d)
#pragma unroll
                for (int i = 0; i < 16; ++i) ot[d][i] *= alpha;
        }
#pragma unroll
        for (int kh = 0; kh < 2; ++kh)
#pragma unroll
            for (int s2 = 0; s2 < 2; ++s2) { u32x4 pa; pa.x = cvtpk(sn[kh][8 * s2], sn[kh][8 * s2 + 1]); pa.y = cvtpk(sn[kh][8 * s2 + 2], sn[kh][8 * s2 + 3]); pa.z = cvtpk(sn[kh][8 * s2 + 4], sn[kh][8 * s2 + 5]); pa.w = cvtpk(sn[kh][8 * s2 + 6], sn[kh][8 * s2 + 7]);
                pp[2 * kh + s2] = pa; }
        { const int n0 = ks1; ks1 = (ks1 + 1) & 3; ks0 = n0; vsm1 = (vsm1 + 1) & 3; vs1 = (vs1 + 1) & 3; }
        asm volatile("s_waitcnt vmcnt(8) lgkmcnt(0)" ::: "memory"); __builtin_amdgcn_s_barrier(); asm volatile("" ::: "memory");
        if (shifted && t1 + 1 < ntile) {
            ps = 0.f;
#pragma unroll
            for (int kh = 0; kh < 2; ++kh)
#pragma unroll
                for (int i = 0; i < 16; ++i) { sc[kh][i] = __builtin_amdgcn_exp2f(sc[kh][i]); ps += sc[kh][i]; }
            l_run += ps;
        }
          }
    }
    { LAS unsigned char* vb = lds + VRING + vsm1 * SLOT + vro;
#pragma unroll
      for (int j = 0; j < 4; ++j) {
          s16x4 lo[4], hi[4];
#pragma unroll
          for (int e = 0; e < 4; ++e) { LAS unsigned char* vp = vb + j * 4096 + ((e ^ q4) * 64);
              lo[e] = __builtin_bit_cast(s16x4, __builtin_amdgcn_ds_read_tr16_b64_v4i16((LAS s16x4*)vp));
              hi[e] = __builtin_bit_cast(s16x4, __builtin_amdgcn_ds_read_tr16_b64_v4i16((LAS s16x4*)(vp + 2048))); }
#pragma unroll
          for (int e = 0; e < 4; ++e) ot[e] = MFMA32(__builtin_shufflevector(lo[e], hi[e], 0, 1, 2, 3, 4, 5, 6, 7), __builtin_bit_cast(bf16x8, pp[j]), ot[e]);
      } }
#undef AT_DMA
#undef AT_ISSUE_K
#undef AT_ISSUE_V
    asm volatile("s_waitcnt vmcnt(0) lgkmcnt(0)" ::: "memory"); __builtin_amdgcn_s_barrier(); asm volatile("" ::: "memory");
    l_run += __shfl_xor(l_run, 32);
    const float inv = 1.f / l_run;
    LAS float* xch = (LAS float*)lds + qg * 4096;
    if (sub == 1) {
        const float sc_ = inv * lam;
#pragma unroll
        for (int d = 0; d < 4; ++d)
#pragma unroll
            for (int g = 0; g < 4; ++g) *(LAS f32x4*)(xch + ((d * 4 + g) * 64 + lane) * 4) = (f32x4){ot[d][4 * g] * sc_, ot[d][4 * g + 1] * sc_, ot[d][4 * g + 2] * sc_, ot[d][4 * g + 3] * sc_};
    }
    __syncthreads();
    if (sub == 0) {
        float ss = 0.f;
#pragma unroll
        for (int d = 0; d < 4; ++d)
#pragma unroll
            for (int g = 0; g < 4; ++g) { const f32x4 xv = *(const LAS f32x4*)(xch + ((d * 4 + g) * 64 + lane) * 4);
#pragma unroll
                for (int e = 0; e < 4; ++e) { const float v = ot[d][4 * g + e] * inv - xv[e]; ot[d][4 * g + e] = v; ss += v * v; } }
        ss += __shfl_xor(ss, 32);
        const float rs = rsqrtf(ss * (1.f / 128.f) + EPS) * (1.f - lam_init);
        bf16_t* op = O + (qrow0 + 32 * qg + r32) * D + h * 128;
#pragma unroll
        for (int d = 0; d < 4; ++d)
#pragma unroll
            for (int g = 0; g < 4; ++g) { const int dv = 32 * d + 8 * g + 4 * hh; const f32x4 gg = *(const f32x4*)(gsub + dv);
                u32x2 w; w.x = cvtpk(ot[d][4 * g] * rs * gg[0], ot[d][4 * g + 1] * rs * gg[1]); w.y = cvtpk(ot[d][4 * g + 2] * rs * gg[2], ot[d][4 * g + 3] * rs * gg[3]);
                *(u32x2*)(op + dv) = w; }
    }
}
DI void attn_phase(unsigned char* sl, bf16_t* O, int layer, bool ctx_out, const float* lamtab, const float* gsub, LAS unsigned char* lds, bool qsplit) {
    const bf16_t* Q = (const bf16_t*)(sl + 2 * SLAB); const bf16_t* Kp = (const bf16_t*)(sl + 3 * SLAB); const bf16_t* Vp = (const bf16_t*)(sl + 4 * SLAB);
    const float lam = lamtab[layer], lam_init = lamtab[2 + layer];
    const int G = gridDim.x; const int vcu = WG_BLOCKED();
    const int nlat = NB * 8 * 32, ntot = nlat + (ctx_out ? NB * 8 * 2 : 0);
    for (int u = vcu; u < ntot; u += G) {
        if (u < nlat) { const int qb = u & 31, bh = u >> 5, h = bh & 7, b = bh >> 3;
            const size_t q0 = (size_t)b * TP + 128 * qb;
            attn_unit((qsplit && q0 < (size_t)PMQ * 256) ? (const bf16_t*)(sl + 6 * SLAB) : Q, Kp, Vp, O, q0, (size_t)b * TP, TP / 64, h, lam, lam_init, gsub, lds); }
        else { const int v = u - nlat; const int qb = v & 1, bh = v >> 1, h = bh & 7, b = bh >> 3;
            const size_t q0 = (size_t)b * TP + TL + 128 * qb;
            attn_unit((qsplit && q0 < (size_t)PMQ * 256) ? (const bf16_t*)(sl + 6 * SLAB) : Q, Kp, Vp, O, q0, (size_t)b * TP + TL, LC / 64, h, lam, lam_init, gsub, lds); }
    }
}

DI void gmlp_phase(unsigned char* sl, const float* ln_g, const float* ln_b, const float* ws_, const float* bs_, bool skipctx, LAS unsigned char* lds) {
    bf16_t* GU = (bf16_t*)(sl + 3 * SLAB); const bf16_t* GV = (const bf16_t*)(sl + 4 * SLAB);
    const int tid = opaque_tid(), lane = tid & 63, wid = __builtin_amdgcn_readfirstlane(tid >> 6), r32 = lane & 31, hh = lane >> 5;
    LAS float* stat = (LAS float*)(lds + 40960);
    const int nitem = NB * 34 * 8;
    for (int it = blockIdx.x; it < nitem; it += gridDim.x) {
        const int g = it & 7, cidx = it >> 3, b = cidx / 34, cc = cidx % 34;
        if (skipctx && cc >= 32) continue;
        const size_t r0 = (size_t)b * TP + 128 * cc;
        __syncthreads();
        if (tid < 128) { const f32x4* pp_ = (const f32x4*)((const float*)(sl + 5 * SLAB) + (r0 + tid) * 32); float sm = 0.f, sq = 0.f;
#pragma unroll
            for (int i = 0; i < 8; ++i) { const f32x4 v = pp_[i]; sm += v[0] + v[2]; sq += v[1] + v[3]; }
            const float mu = sm * (1.f / 1024.f); const float var = fmaxf(sq * (1.f / 1024.f) - mu * mu, 0.f);
            stat[2 * tid] = mu; stat[2 * tid + 1] = rsqrtf(var + EPS); }
        __syncthreads();
        { const int s = tid >> 2, qd = tid & 3; const bf16_t* rp = GV + (r0 + s) * D + g * 128 + qd * 32; const float mu = stat[2 * s], rs = stat[2 * s + 1];
#pragma unroll
          for (int i = 0; i < 4; ++i) { const u32x4 w = *(const u32x4*)(rp + 8 * i);
              const int cb_ = g * 128 + qd * 32 + 8 * i; const f32x4 lg0 = *(const f32x4*)(ln_g + cb_), lg1 = *(const f32x4*)(ln_g + cb_ + 4), lb0 = *(const f32x4*)(ln_b + cb_), lb1 = *(const f32x4*)(ln_b + cb_ + 4);
#pragma unroll
              for (int e = 0; e < 4; ++e) { const int c = qd * 32 + 8 * i + 2 * e;
                  const float ga = (e < 2) ? lg0[2 * e] : lg1[2 * e - 4], gb = (e < 2) ? lg0[2 * e + 1] : lg1[2 * e - 3], ba = (e < 2) ? lb0[2 * e] : lb1[2 * e - 4], bb = (e < 2) ? lb0[2 * e + 1] : lb1[2 * e - 3];
                  const float v0 = (bflo(w[e]) - mu) * rs * ga + ba, v1 = (bfhi(w[e]) - mu) * rs * gb + bb;
                  *(LAS unsigned short*)(lds + c * 272 + s * 2) = f2bf(v0); *(LAS unsigned short*)(lds + (c + 1) * 272 + s * 2) = f2bf(v1); } } }
        __syncthreads();
        const int tb = wid >> 1, cb0 = 2 * (wid & 1);
        f32x16 acc[2];
#pragma unroll
        for (int t = 0; t < 2; ++t)
#pragma unroll
            for (int i = 0; i < 16; ++i) acc[t][i] = 0.f;
        const float* wrow = ws_ + ((size_t)g * 128 + 32 * tb + r32) * 128 + 8 * hh;
#pragma unroll
        for (int s = 0; s < 8; ++s) { const f32x4 w0 = *(const f32x4*)(wrow + 16 * s), w1 = *(const f32x4*)(wrow + 16 * s + 4);
            u32x4 pa; pa.x = cvtpk(w0[0], w0[1]); pa.y = cvtpk(w0[2], w0[3]); pa.z = cvtpk(w1[0], w1[1]); pa.w = cvtpk(w1[2], w1[3]);
            const bf16x8 af = __builtin_bit_cast(bf16x8, pa);
#pragma unroll
            for (int t = 0; t < 2; ++t) { const bf16x8 bfv = *(const LAS bf16x8*)(lds + (32 * (cb0 + t) + r32) * 272 + (16 * s + 8 * hh) * 2); acc[t] = MFMA32(bfv, af, acc[t]); } }
        { const int tt = 32 * tb + r32; const float bias = bs_[g * 128 + tt];
#pragma unroll
          for (int t = 0; t < 2; ++t)
#pragma unroll
            for (int g4 = 0; g4 < 4; ++g4) { const size_t off = (r0 + tt) * D + g * 128 + 32 * (cb0 + t) + 8 * g4 + 4 * hh;
                const u32x2 gu = *(const u32x2*)(GU + off);
                u32x2 w; w.x = cvtpk(bflo(gu.x) * (acc[t][4 * g4] + bias), bfhi(gu.x) * (acc[t][4 * g4 + 1] + bias)); w.y = cvtpk(bflo(gu.y) * (acc[t][4 * g4 + 2] + bias), bfhi(gu.y) * (acc[t][4 * g4 + 3] + bias));
                *(u32x2*)(GU + off) = w; } }
    }
}

DI void act_phase(const bf16_t* U, bf16_t* ACT, const float* cw, const float* cb, int hf, bool skipctx, int ngt) {
    const int gtid = blockIdx.x * NTHR + opaque_tid();
    constexpr int NCH = DFFH / 8, NSTRIP = M / 16;
    for (int idx = gtid; idx < NSTRIP * NCH; idx += ngt) {
        const int strip = idx / NCH, ch = idx - strip * NCH; const int r0 = strip * 16; const int p0 = r0 % TP;
        if (skipctx && p0 >= TL) continue;
        const int c = ch * 8; const int ca = DFFH * hf + c, cbn = DFF + DFFH * hf + c;
        f32x4 wa[3][2], wb[3][2], ba[2], bb[2];
#pragma unroll
        for (int j = 0; j < 3; ++j) { wa[j][0] = *(const f32x4*)(cw + j * 2 * DFF + ca); wa[j][1] = *(const f32x4*)(cw + j * 2 * DFF + ca + 4); wb[j][0] = *(const f32x4*)(cw + j * 2 * DFF + cbn); wb[j][1] = *(const f32x4*)(cw + j * 2 * DFF + cbn + 4); }
        ba[0] = *(const f32x4*)(cb + ca); ba[1] = *(const f32x4*)(cb + ca + 4); bb[0] = *(const f32x4*)(cb + cbn); bb[1] = *(const f32x4*)(cb + cbn + 4);
        const bf16_t* up = U + (size_t)r0 * DFF + c; bf16_t* op = ACT + (size_t)r0 * DFF + DFFH * hf + c;
        const bool has_prev = (p0 != 0 && p0 != TL), has_next = (p0 + 16 != TL && p0 + 16 != TP);
        const u32x4 z = {0u, 0u, 0u, 0u};
        u32x4 a0 = has_prev ? *(const u32x4*)(up - DFF) : z, b0 = has_prev ? *(const u32x4*)(up - DFF + DFFH) : z;
        u32x4 a1 = *(const u32x4*)up, b1 = *(const u32x4*)(up + DFFH);
#pragma unroll 4
        for (int i = 0; i < 16; ++i) {
            const bool nx = (i < 15) || has_next;
            const u32x4 a2 = nx ? *(const u32x4*)(up + (size_t)(i + 1) * DFF) : z, b2 = nx ? *(const u32x4*)(up + (size_t)(i + 1) * DFF + DFFH) : z;
            u32x4 w;
#pragma unroll
            for (int e = 0; e < 4; ++e) {
                const int v = e >> 1, q0 = (2 * e) & 3, q1 = q0 + 1;
                const float av0 = wa[0][v][q0] * bflo(a0[e]) + wa[1][v][q0] * bflo(a1[e]) + wa[2][v][q0] * bflo(a2[e]) + ba[v][q0];
                const float av1 = wa[0][v][q1] * bfhi(a0[e]) + wa[1][v][q1] * bfhi(a1[e]) + wa[2][v][q1] * bfhi(a2[e]) + ba[v][q1];
                const float bv0 = wb[0][v][q0] * bflo(b0[e]) + wb[1][v][q0] * bflo(b1[e]) + wb[2][v][q0] * bflo(b2[e]) + bb[v][q0];
                const float bv1 = wb[0][v][q1] * bfhi(b0[e]) + wb[1][v][q1] * bfhi(b1[e]) + wb[2][v][q1] * bfhi(b2[e]) + bb[v][q1];
                w[e] = cvtpk(silu_f(av0) * bv0, silu_f(av1) * bv1);
            }
            *(u32x4*)(op + (size_t)i * DFF) = w;
            a0 = a1; a1 = a2; b0 = b1; b1 = b2;
        }
    }
}

#define XB_TMO      128
#define XB_XCNT(j)  (256  + 64 * (j))
#define XB_XSUB(j)  (1280 + 64 * (j))
#define XB_XGEN(j)  (2304 + 64 * (j))
#define XB_TOP      3328
#define XB_TOPGEN   3392
#define XCD_BAR_WORDS 3456
#define XB_SPIN_CAP (1u << 20)
DI unsigned xb_ld(unsigned* p)              { return __hip_atomic_load(p, __ATOMIC_RELAXED, __HIP_MEMORY_SCOPE_AGENT); }
DI unsigned xb_add(unsigned* p, unsigned v) { return __hip_atomic_fetch_add(p, v, __ATOMIC_RELAXED, __HIP_MEMORY_SCOPE_AGENT); }
DI unsigned xb_xcc_id() { return (unsigned)__builtin_amdgcn_s_getreg((3 << 11) | 20) & 0xFu; }
#define XB_SPIN(cond, bar) do { unsigned _sp = 0; while (cond) { __builtin_amdgcn_s_sleep(6); \
    if ((++_sp & 255u) == 0u) { if (xb_ld(&(bar)[XB_TMO])) break; if (_sp > XB_SPIN_CAP) { atomicAdd(&(bar)[XB_TMO], 1u); break; } } } } while (0)
struct XcdBarrier { unsigned* bar; unsigned x; volatile LAS unsigned* st; };
DI XcdBarrier xcd_barrier_post(unsigned* bar, volatile LAS unsigned* st) {
    XcdBarrier b; b.bar = bar; b.x = xb_xcc_id(); b.st = st;
    if (threadIdx.x == 0) { st[2] = xb_add(&bar[XB_XCNT(b.x)], 1u); st[3] = b.x; }
    return b;
}
DI void xcd_barrier_complete(unsigned* bar, unsigned x, unsigned& nloc, unsigned& nx) {
    const unsigned G = gridDim.x * gridDim.y * gridDim.z;
    unsigned sum, cnt, mine, sp = 0u;
    for (;;) {
        sum = 0u; cnt = 0u; mine = 0u;
#pragma unroll
        for (unsigned j = 0; j < 16; ++j) { const unsigned c = xb_ld(&bar[XB_XCNT(j)]); sum += c; cnt += (c > 0u) ? 1u : 0u; mine = (j == x) ? c : mine; }
        if (sum == G) break;
        __builtin_amdgcn_s_sleep(1);
        if ((++sp & 255u) == 0u) { if (xb_ld(&bar[XB_TMO])) break; if (sp > XB_SPIN_CAP) { atomicAdd(&bar[XB_TMO], 1u); break; } }
    }
    nloc = mine > 0u ? mine : 1u; nx = cnt > 0u ? cnt : 1u;
}
DI void xcd_barrier(const XcdBarrier& b) {
    asm volatile("s_waitcnt vmcnt(0)" ::: "memory");
    __syncthreads();
    if (threadIdx.x == 0) {
        unsigned* bar = b.bar;
        __builtin_amdgcn_s_waitcnt(0);
        unsigned nloc = b.st[0], nx = b.st[1];
        if (nloc == 0u) { xcd_barrier_complete(bar, b.x, nloc, nx); b.st[0] = nloc; b.st[1] = nx; }
        const unsigned old = xb_add(&bar[XB_XSUB(b.x)], 1u);
        const unsigned gen = old / nloc;
        if (old + 1u == (gen + 1u) * nloc) {
            __builtin_amdgcn_fence(__ATOMIC_RELEASE, "agent");
            asm volatile("s_waitcnt vmcnt(0)" ::: "memory");
            const unsigned og = xb_add(&bar[XB_TOP], 1u);
            const unsigned tg = og / nx;
            if (og + 1u == (tg + 1u) * nx) xb_add(&bar[XB_TOPGEN], 1u);
            else XB_SPIN(xb_ld(&bar[XB_TOPGEN]) == tg, bar);
            __builtin_amdgcn_fence(__ATOMIC_ACQUIRE, "agent");
            xb_add(&bar[XB_XGEN(b.x)], 1u);
            asm volatile("s_waitcnt vmcnt(0)" ::: "memory");
        } else {
            XB_SPIN(xb_ld(&bar[XB_XGEN(b.x)]) == gen, bar);
            __builtin_amdgcn_fence(__ATOMIC_ACQUIRE, "agent");
            asm volatile("s_waitcnt vmcnt(0)" ::: "memory");
        }
    }
    __syncthreads();
}

DI void xcd_ids(const XcdBarrier& b) {
    if (threadIdx.x == 0) {
        const unsigned rank = b.st[2], x = b.st[3]; unsigned blocked = rank, inter = 0u;
#pragma unroll
        for (unsigned j = 0; j < 16; ++j) { const unsigned c = xb_ld(&b.bar[XB_XCNT(j)]); if (j < x) blocked += c; inter += (c < rank ? c : rank) + ((j < x && c > rank) ? 1u : 0u); }
        b.st[4] = blocked; b.st[5] = inter;
    }
    __syncthreads();
}
#ifndef PROBE_ATT
#define PROBE_ATT 0
#endif
#ifndef PROBE_SCAN
#define PROBE_SCAN 0
#endif
#ifndef PROBE_GEMM
#define PROBE_GEMM 0
#endif
#define GREP for (int rep_ = 0; rep_ < (PROBE_GEMM ? 2 : 1); ++rep_)
#ifndef PROBE_SYNC
#define PROBE_SYNC 0
#endif
#define GSYNC() do { xcd_barrier(xbar); if (PROBE_SYNC) xcd_barrier(xbar); } while (0)
#ifndef PH_MASK
#define PH_MASK 0xFFFFF
#endif
#define PH(b) if ((PH_MASK >> (b)) & 1)
#define WSP (KWS())
#define SLP (KWS() + WS_SL)
#define MODP ((const float*)(KWS() + TAB_MOD))
#define ROPEP ((const float*)(KWS() + TAB_ROPE))
#define LBTP ((const float*)(KWS() + TAB_LB))
#define LAMTP ((const float*)(KWS() + TAB_LAM))
#define XCP ((float*)(KWS() + WS_XC))
#define MODL (MODP + (size_t)l * 9 * 6144)
#define UP_ ((bf16_t*)(SLP + 1 * SLAB))
#define ACTP ((bf16_t*)(SLP + SLAB * 15 / 4))
__global__ void __launch_bounds__(NTHR, 2) fwd_megakernel(Ptrs P) {
    extern __shared__ __attribute__((aligned(16))) unsigned char lds_raw[];
    LAS unsigned char* lds = (LAS unsigned char*)lds_raw;
    cg::grid_group grid = cg::this_grid();
    const int G = gridDim.x, NGW = G * NWAVES, ngt = G * NTHR;
    const size_t TS = (size_t)256 * D * 2;

    unsigned* barw = (unsigned*)(WSP + WS_BAR);
    if (gridDim.x == 0x7fffffffu) grid.sync();
    if (threadIdx.x < 16) ((volatile LAS unsigned*)(lds + LDS_BYTES - 64))[threadIdx.x] = 0u;
    __syncthreads();
    const XcdBarrier xbar = xcd_barrier_post(barw, (volatile LAS unsigned*)(lds + LDS_BYTES - 64));
    PH(0) p0_tables(lds);
    __syncthreads();
    PH(1) convert_weights(0, lds, NGW);
    GSYNC();
    xcd_ids(xbar);
    PH(2) { RW a{}; a.xin_lat = KP(x); a.xin_ctx = KP(ctx); a.Y = nullptr; a.g_pre = KP(g_pre_mix); a.modB = MODP; a.sh_chunk = 0; a.H = (bf16_t*)SLP; a.skipctx = 0; rw_phase(a, NGW); }
    GSYNC();

    for (int l = 0; l < 2; ++l) {
        const bool last = (l == 1); const int skc = last ? 1 : 0;
        const bool hg_split = (G >= 256);
        PH(3) GREP { SchedHG S; S.o.init(136, hg_split ? 16 : 20, G, WG_INTER()); S.A = (const char*)SLP; S.B = (const char*)(WSP + WS_WIN); S.tstep = TS; S.extra = (hg_split && !last) ? 32 : 0; S.qextra = hg_split ? PMQ * 4 : 0;
          EpiIn E{SLP, 0, LBTP + l * 2048, ROPEP}; pg8::gemm_phase(lds, D, S, E); }
        GSYNC();
        if (PROBE_SCAN) { scan_phase(SLP, l, !last, WSP == nullptr, lds); }
        PH(4) scan_phase(SLP, l, !last, true, lds);
        if (hg_split && blockIdx.x >= 128) {
            SchedG S; S.o.init(128, 4, G - 128, (int)blockIdx.x - 128); S.A = (const char*)SLP; S.B = (const char*)(WSP + WS_WIN) + (size_t)4096 * D * 2; S.tstep = TS; S.skipctx = 1;
            EpiIn E{SLP, 3, nullptr, nullptr}; pg8::gemm_phase(lds, D, S, E); }
        GSYNC();
        PH(5) combine_phase(SLP, KP(hg_norm_g) + l * 128, last, NGW);
        GSYNC();
        PH(6) GREP { SchedATQ S; S.o.init(136, 8, G, WG_INTER()); S.A = (const char*)SLP; S.B = (const char*)(WSP + WS_WIN) + (size_t)5120 * D * 2; S.tstep = TS; S.qfirst = hg_split ? PMQ : 0;
          EpiIn E{SLP, 1, nullptr, ROPEP}; pg8::gemm_phase(lds, D, S, E); }
        GSYNC();
        if (PROBE_ATT) { attn_phase(SLP, (bf16_t*)(SLP + 5 * SLAB), l, !last, LAMTP, KP(att_subln_g) + l * 128, lds, hg_split); }
        PH(7) attn_phase(SLP, (bf16_t*)(SLP + 2 * SLAB), l, !last, LAMTP, KP(att_subln_g) + l * 128, lds, hg_split);
        GSYNC();
        PH(8) GREP { SchedG S; S.o.init(last ? 128 : 136, 8, G, WG_INTER()); S.A = (const char*)SLP; S.B = (const char*)(WSP + WS_WIN) + (size_t)8192 * D * 2; S.tstep = TS; S.skipctx = skc;
          EpiIn E{SLP, 2, nullptr, ROPEP}; pg8::gemm_phase(lds, D, S, E); }
        GSYNC();
        PH(9) gmlp_phase(SLP, KP(gm_ln_g) + l * 1024, KP(gm_ln_b) + l * 1024, KP(gm_ws) + (size_t)l * 8 * 128 * 128, KP(gm_bs) + l * 1024, last, lds);
        GSYNC();
        PH(10) GREP { SchedM S; S.o.init(last ? 128 : 136, 4, G, WG_INTER()); S.ws = (const char*)WSP; S.skipctx = skc;
          EpiMerge E{SLP + 5 * SLAB + (size_t)blockIdx.x * (48 * 512 * 16), (bf16_t*)(SLP + 4 * SLAB)}; pg8::gemm_phase(lds, D, S, E); }
        GSYNC();
        PH(11) GREP { SchedG S; S.o.init(last ? 128 : 136, 4, G, WG_INTER()); S.A = (const char*)(SLP + 4 * SLAB); S.B = (const char*)(WSP + WS_WOUT); S.tstep = TS; S.skipctx = skc;
          EpiB16 E{(bf16_t*)(SLP + 2 * SLAB), D}; pg8::gemm_phase(lds, D, S, E); }
        GSYNC();
        PH(12) { RW a{}; a.xin_lat = (l == 0) ? KP(x) : KOUT(); a.xin_ctx = (l == 0) ? KP(ctx) : XCP; a.xo_lat = KOUT(); a.xo_ctx = XCP; a.Y = (const bf16_t*)(SLP + 2 * SLAB); a.g_post = KP(g_post_mix) + l * D; a.modA = MODL; a.gate_chunk = 2;
          a.g_pre = KP(g_pre_ffn) + l * D; a.modB = MODL; a.sh_chunk = 3; a.H = (bf16_t*)SLP; a.skipctx = skc; rw_phase(a, NGW); }
        GSYNC();
        for (int hf = 0; hf < 2; ++hf) {
            PH(13) GREP { SchedG S; S.o.init(last ? 128 : 136, 11, G, WG_INTER()); S.A = (const char*)SLP; S.B = (const char*)(WSP + WS_WUP) + (size_t)hf * DFF * D * 2; S.tstep = TS; S.skipctx = skc;
              EpiB16 E{UP_, DFF}; pg8::gemm_phase(lds, D, S, E); }
            GSYNC();
            PH(14) act_phase(UP_, ACTP, KP(conv_w) + (size_t)l * 3 * 2 * DFF, KP(conv_b) + (size_t)l * 2 * DFF, hf, last, ngt);
            GSYNC();
        }
        PH(15) GREP { SchedG S; S.o.init(last ? 128 : 136, 4, G, WG_INTER()); S.A = (const char*)ACTP; S.B = (const char*)(WSP + WS_WDN); S.tstep = (size_t)256 * DFF * 2; S.skipctx = skc;
          EpiB16 E{(bf16_t*)(SLP + 1 * SLAB), D}; pg8::gemm_phase(lds, DFF, S, E); }
        GSYNC();
        PH(16) { RW a{}; a.xin_lat = KOUT(); a.xin_ctx = XCP; a.xo_lat = KOUT(); a.xo_ctx = XCP; a.Y = (const bf16_t*)(SLP + 1 * SLAB); a.g_post = KP(g_post_ffn) + l * D; a.modA = MODL; a.gate_chunk = 5;
          if (!last) { a.g_pre = KP(g_pre_mix) + (l + 1) * D; a.modB = MODP + (size_t)(l + 1) * 9 * 6144; a.sh_chunk = 0; a.H = (bf16_t*)SLP; }
          a.skipctx = skc; rw_phase(a, NGW); }
        PH(17) if (!last) { convert_weights(l + 1, lds, NGW); GSYNC(); }
    }
}

extern "C" void kernel_launch(void* const* d_in, const int* in_sizes, int n_in, void* d_out, int out_size, void* d_ws, size_t ws_size, hipStream_t stream) {
    static int grid = 0;
    if (grid == 0) {
        if (n_in != 30 || ws_size < WS_END) { fprintf(stderr, "kernel_launch: need 30 inputs and >= %zu bytes of workspace (got %d, %zu)\n", (size_t)WS_END, n_in, ws_size); grid = -1; return; }
        int dev = 0, cus = 0, per_cu = 0;
        hipGetDevice(&dev); hipDeviceGetAttribute(&cus, hipDeviceAttributeMultiprocessorCount, dev);
        hipFuncSetAttribute((const void*)fwd_megakernel, hipFuncAttributeMaxDynamicSharedMemorySize, LDS_BYTES);
        hipOccupancyMaxActiveBlocksPerMultiprocessor(&per_cu, (const void*)fwd_megakernel, NTHR, LDS_BYTES);
        (void)hipGetLastError();
        if (per_cu < 1) per_cu = 1;
        grid = cus * 1;
    }
    if (grid < 0) return;
    Ptrs p{};
    const float** pp = (const float**)&p;
    for (int i = 0; i < 30; ++i) pp[i] = (const float*)d_in[i];
    p.out = (float*)d_out; p.ws = (unsigned char*)d_ws;
    void* args[] = {&p};
    if (hipMemsetAsync((char*)d_ws + WS_BAR, 0, XCD_BAR_WORDS * 4, stream) != hipSuccess) { fprintf(stderr, "kernel_launch: hipMemsetAsync of the barrier words failed\n"); return; }
    hipError_t e = hipLaunchCooperativeKernel((const void*)fwd_megakernel, dim3(grid), dim3(NTHR), args, LDS_BYTES, stream);
    if (e != hipSuccess) fprintf(stderr, "cooperative launch failed: %s (grid %d)\n", hipGetErrorString(e), grid);
}
```
